# Optimizing an MI355X kernel written in HIP

```python
import math
import jax, jax.numpy as jnp
from jax import lax
import numpy as np

D_MODEL = 1024
BATCH = 16
SEQ = 4096
DEPTH = 1

CHUNK = 64
Q_BLOCK = 128
TOKEN_BLOCK = 128
EPS = 1e-6

SB_HEADS = 8
SB_HEAD_DIM = 64
SB_WIDTH = SB_HEADS * SB_HEAD_DIM

MLA_HEADS = 8
MLA_NOPE_DIM = 64
MLA_ROPE_DIM = 32
MLA_QK_DIM = MLA_NOPE_DIM + MLA_ROPE_DIM
MLA_V_DIM = 64
MLA_Q_RANK = 384
MLA_KV_RANK = 256
MLA_WIDTH = MLA_HEADS * MLA_V_DIM
ROPE_THETA = 10000.0

MIX_WIDTH = SB_WIDTH + MLA_WIDTH
IN_SPLITS = (SB_WIDTH, 2 * SB_WIDTH, 3 * SB_WIDTH,
             3 * SB_WIDTH + MLA_Q_RANK,
             3 * SB_WIDTH + MLA_Q_RANK + MLA_KV_RANK)
IN_PROJ_WIDTH = 3 * SB_WIDTH + MLA_Q_RANK + MLA_KV_RANK + MLA_ROPE_DIM

PEER_HEADS = 8
PEER_N_KEYS = 128
PEER_N_EXPERTS = PEER_N_KEYS * PEER_N_KEYS
PEER_KEY_DIM = 256
PEER_HALF_DIM = PEER_KEY_DIM // 2
PEER_TOPK = 16

kernel_name = "hybrid_stickbreak_mla_peer_block"


def rms_norm(x, g):
    xf = x.astype(jnp.float32)
    y = xf * lax.rsqrt(jnp.mean(xf * xf, axis=-1, keepdims=True) + EPS)
    return (y * g.astype(jnp.float32)).astype(x.dtype)


def rope(x, pos):
    r = x.shape[-1]
    half = r // 2
    inv_freq = 1.0 / (ROPE_THETA ** (jnp.arange(half, dtype=jnp.float32) * (2.0 / r)))
    ang = pos.astype(jnp.float32)[..., None] * inv_freq
    cos = jnp.cos(ang)[:, :, None, :]
    sin = jnp.sin(ang)[:, :, None, :]
    xf = x.astype(jnp.float32)
    x1, x2 = xf[..., :half], xf[..., half:]
    out = jnp.concatenate([x1 * cos - x2 * sin, x1 * sin + x2 * cos], axis=-1)
    return out.astype(x.dtype)


def to_query_blocks(q):
    b, s, h, d = q.shape
    return q.reshape(b, s // Q_BLOCK, Q_BLOCK, h, d).transpose(1, 0, 3, 2, 4)


def from_query_blocks(o):
    nb, b, qb, h, d = o.shape
    return o.transpose(1, 0, 2, 3, 4).reshape(b, nb * qb, h * d)


def stick_breaking_attention(q, k, v):
    b, s, h, d = q.shape
    nb = s // Q_BLOCK
    scale = d ** -0.5
    kpos = jnp.arange(s)

    def block(args):
        qi, bi = args
        z = jnp.einsum('bhqd,bshd->bhqs', qi, k,
                       preferred_element_type=jnp.float32) * scale
        qpos = bi * Q_BLOCK + jnp.arange(Q_BLOCK)
        strict = kpos[None, :] < qpos[:, None]
        log_fail = jnp.where(strict, jax.nn.log_sigmoid(-z), 0.0)
        later = lax.cumsum(log_fail, axis=3, reverse=True) - log_fail
        a = jnp.where(strict, jnp.exp(jax.nn.log_sigmoid(z) + later), 0.0)
        return jnp.einsum('bhqs,bshd->bqhd', a.astype(v.dtype), v)

    out = lax.map(block, (to_query_blocks(q), jnp.arange(nb)))
    return from_query_blocks(out)


def chunk_causal_softmax_attention(q, k, v):
    b, s, h, dq = q.shape
    nb = s // Q_BLOCK
    scale = dq ** -0.5
    kchunk = jnp.arange(s) // CHUNK

    def block(args):
        qi, bi = args
        sc = jnp.einsum('bhqd,bshd->bhqs', qi, k,
                        preferred_element_type=jnp.float32) * scale
        qchunk = (bi * Q_BLOCK + jnp.arange(Q_BLOCK)) // CHUNK
        allowed = kchunk[None, :] <= qchunk[:, None]
        p = jax.nn.softmax(jnp.where(allowed, sc, -jnp.inf), axis=-1)
        return jnp.einsum('bhqs,bshd->bqhd', p.astype(v.dtype), v)

    out = lax.map(block, (to_query_blocks(q), jnp.arange(nb)))
    return from_query_blocks(out)


def peer_ffn(h, w_q, sub_keys, u, v):
    b, s, d = h.shape
    nb = (b * s) // TOKEN_BLOCK
    k = PEER_TOPK

    def block(xt):
        q = (xt @ w_q).reshape(TOKEN_BLOCK, PEER_HEADS, 2, PEER_HALF_DIM)
        sc = jnp.einsum('thcd,chnd->thcn', q, sub_keys,
                        preferred_element_type=jnp.float32)
        top_s, top_i = lax.top_k(sc, k)
        cand_s = top_s[:, :, 0, :, None] + top_s[:, :, 1, None, :]
        cand_i = top_i[:, :, 0, :, None] * PEER_N_KEYS + top_i[:, :, 1, None, :]
        best_s, best_pos = lax.top_k(cand_s.reshape(TOKEN_BLOCK, PEER_HEADS, k * k), k)
        idx = jnp.take_along_axis(cand_i.reshape(TOKEN_BLOCK, PEER_HEADS, k * k),
                                  best_pos, axis=-1)
        g = jax.nn.softmax(best_s, axis=-1)
        pre = jnp.einsum('td,thkd->thk', xt, u[idx], preferred_element_type=jnp.float32)
        coef = (g * jax.nn.gelu(pre, approximate=False)).astype(v.dtype)
        return jnp.einsum('thk,thkd->td', coef, v[idx])

    out = lax.map(block, h.reshape(nb, TOKEN_BLOCK, d))
    return out.reshape(b, s, d)


def setup_inputs(seed: int = 0) -> dict:
    key = jax.random.key(seed)
    ks = jax.random.split(key, 20)
    f32 = jnp.float32

    def w(k_, shape, fan_in):
        return jax.random.normal(k_, shape, f32) * (fan_in ** -0.5)

    def gain(k_, shape):
        return 1.0 + 0.02 * jax.random.normal(k_, shape, f32)

    x = jax.random.normal(ks[0], (BATCH, SEQ, D_MODEL), f32)
    offset = jax.random.randint(ks[1], (BATCH, 1), 0, 1024, dtype=jnp.int32)
    positions = (offset + jnp.arange(SEQ, dtype=jnp.int32)[None, :]).astype(jnp.int32)
    return {
        "x": x,
        "positions": positions,
        "attn_norm": gain(ks[2], (DEPTH, D_MODEL)),
        "w_in": w(ks[3], (DEPTH, D_MODEL, IN_PROJ_WIDTH), D_MODEL),
        "cq_norm": gain(ks[4], (DEPTH, MLA_Q_RANK)),
        "w_uq": w(ks[5], (DEPTH, MLA_Q_RANK, MLA_HEADS * MLA_QK_DIM), MLA_Q_RANK),
        "ckv_norm": gain(ks[6], (DEPTH, MLA_KV_RANK)),
        "w_ukv": w(ks[7], (DEPTH, MLA_KV_RANK, MLA_HEADS * (MLA_NOPE_DIM + MLA_V_DIM)), MLA_KV_RANK),
        "q_norm": gain(ks[8], (DEPTH, MLA_QK_DIM)),
        "k_norm": gain(ks[9], (DEPTH, MLA_QK_DIM)),
        "sb_out_norm": gain(ks[10], (DEPTH, SB_WIDTH)),
        "mla_out_norm": gain(ks[11], (DEPTH, MLA_WIDTH)),
        "w_o": w(ks[12], (DEPTH, MIX_WIDTH, D_MODEL), MIX_WIDTH),
        "ffn_norm": gain(ks[13], (DEPTH, D_MODEL)),
        "peer_w_q": w(ks[14], (DEPTH, D_MODEL, PEER_HEADS * PEER_KEY_DIM), D_MODEL),
        "peer_sub_keys": w(ks[15], (DEPTH, 2, PEER_HEADS, PEER_N_KEYS, PEER_HALF_DIM), PEER_HALF_DIM),
        "peer_u": w(ks[16], (DEPTH, PEER_N_EXPERTS, D_MODEL), D_MODEL),
        "peer_v": w(ks[17], (DEPTH, PEER_N_EXPERTS, D_MODEL), D_MODEL),
    }


def reference(x, positions, attn_norm, w_in, cq_norm, w_uq, ckv_norm, w_ukv, q_norm, k_norm,
              sb_out_norm, mla_out_norm, w_o, ffn_norm, peer_w_q, peer_sub_keys, peer_u, peer_v):
    b, s, _ = x.shape
    for l in range(DEPTH):
        h = rms_norm(x, attn_norm[l])
        proj = h @ w_in[l]
        sb_q, sb_k, sb_v, cq, ckv, k_pe = jnp.split(proj, IN_SPLITS, axis=-1)

        sb = stick_breaking_attention(sb_q.reshape(b, s, SB_HEADS, SB_HEAD_DIM),
                                      sb_k.reshape(b, s, SB_HEADS, SB_HEAD_DIM),
                                      sb_v.reshape(b, s, SB_HEADS, SB_HEAD_DIM))

        q = (rms_norm(cq, cq_norm[l]) @ w_uq[l]).reshape(b, s, MLA_HEADS, MLA_QK_DIM)
        kv = (rms_norm(ckv, ckv_norm[l]) @ w_ukv[l]).reshape(b, s, MLA_HEADS, MLA_NOPE_DIM + MLA_V_DIM)
        k_nope, v = kv[..., :MLA_NOPE_DIM], kv[..., MLA_NOPE_DIM:]
        k_rot = jnp.broadcast_to(k_pe[:, :, None, :], (b, s, MLA_HEADS, MLA_ROPE_DIM))
        k = jnp.concatenate([k_nope, k_rot], axis=-1)
        q = rms_norm(q, q_norm[l])
        k = rms_norm(k, k_norm[l])
        q = jnp.concatenate([q[..., :MLA_NOPE_DIM], rope(q[..., MLA_NOPE_DIM:], positions)], axis=-1)
        k = jnp.concatenate([k[..., :MLA_NOPE_DIM], rope(k[..., MLA_NOPE_DIM:], positions)], axis=-1)
        mla = chunk_causal_softmax_attention(q, k, v)

        mixed = jnp.concatenate([rms_norm(sb, sb_out_norm[l]),
                                 rms_norm(mla, mla_out_norm[l])], axis=-1)
        x = x + mixed @ w_o[l]

        x = x + peer_ffn(rms_norm(x, ffn_norm[l]), peer_w_q[l], peer_sub_keys[l],
                         peer_u[l], peer_v[l])
    return x
```

```cpp
#include <hip/hip_runtime.h>
#include <hip/hip_cooperative_groups.h>
#include <cstdio>
namespace cg = cooperative_groups;

typedef unsigned short u16;
typedef unsigned int u32;
typedef short bf16x8 __attribute__((ext_vector_type(8)));
typedef float f32x16 __attribute__((ext_vector_type(16)));
typedef float f32x2 __attribute__((ext_vector_type(2)));
typedef __bf16 bf16x2_t __attribute__((ext_vector_type(2)));
#define DI __device__ __forceinline__

#define NTOK 65536
#define SEQ 4096
#define NB 16
#define DM 1024
#define INW 2208
#define INW_PAD 2304
#define NTHREADS 512

#define MB_ (1024ull * 1024ull)
#define WS_XB    (0ull)
#define WS_WINT  (128 * MB_)
#define WS_WUQT  (WS_WINT + 4718592ull)
#define WS_WUKVT (WS_WUQT + 589824ull)
#define WS_WOT   (WS_WUKVT + 524288ull)
#define WS_WPQT  (WS_WOT + 2097152ull)
#define WS_SUBK  (WS_WPQT + 4194304ull)
#define WS_UB    (WS_SUBK + 524288ull)
#define WS_VB    (WS_UB + 16 * MB_)
#define WS_RX    (WS_VB + 16 * MB_ + 131072ull)
#define WS_USC   (WS_VB + 16 * MB_)
#define WS_VSC   (WS_USC + 65536ull)
#define WS_R2    (WS_VB + 48 * MB_ + 1 * MB_)
#define WS_SBQ   (WS_R2)
#define WS_SBK   (WS_R2 + 64 * MB_)
#define WS_SBVT  (WS_R2 + 128 * MB_)
#define WS_IDX   (WS_R2)
#define WS_GATE  (WS_R2 + 32 * MB_)
#define WS_R3    (WS_R2 + 192 * MB_)
#define WS_CQ    (WS_R3)
#define WS_CKV   (WS_R3 + 48 * MB_)
#define WS_KPE   (WS_R3 + 80 * MB_)
#define WS_R4    (WS_R3 + 128 * MB_)
#define WS_MQ    (WS_R4)
#define WS_MK    (WS_R4 + 96 * MB_)
#define WS_MVT   (WS_R4 + 192 * MB_)
#define WS_SBO   (WS_R4 + 256 * MB_)
#define WS_MLAO  (WS_SBO + 64 * MB_)
#define WS_END   (WS_MLAO + 64 * MB_)

struct Params {
  const float* x; const int* pos; const float* attn_norm; const float* w_in; const float* cq_norm; const float* w_uq;
  const float* ckv_norm; const float* w_ukv; const float* q_norm; const float* k_norm; const float* sb_out_norm;
  const float* mla_out_norm; const float* w_o; const float* ffn_norm; const float* peer_wq; const float* peer_sk;
  const float* peer_u; const float* peer_v;
  float* out; char* ws;
  int ph_lo, ph_hi;
};

DI u32 pk_bf16(float a, float b) {
  f32x2 v = {a, b};
  bf16x2_t r = __builtin_convertvector(v, bf16x2_t);
  return __builtin_bit_cast(u32, r);
}
DI u16 f2bf(float a) { return (u16)(pk_bf16(a, 0.f) & 0xffffu); }
DI float bf_lo(u32 w) { return __uint_as_float(w << 16); }
DI float bf_hi(u32 w) { return __uint_as_float(w & 0xffff0000u); }
DI int crow(int reg, int h) { return (reg & 3) + 8 * (reg >> 2) + 4 * h; }
DI int swap23(int a) { return (a & ~12) | ((a >> 1) & 4) | ((a << 1) & 8); }
#define MFMA32(a, b, c) __builtin_amdgcn_mfma_f32_32x32x16_bf16((a), (b), (c), 0, 0, 0)
DI float shfl_xor_f(float v, int m) { return __shfl_xor(v, m, 64); }
DI int opaque_tid() { int t = threadIdx.x; asm volatile("" : "+v"(t)); return t; }
#ifndef XCD_CONSECUTIVE
#define XCD_CONSECUTIVE 0
#endif
#if XCD_CONSECUTIVE
#define VXCD ((int)(blockIdx.x / (gridDim.x >> 3)))
#define VCU  ((int)(blockIdx.x % (gridDim.x >> 3)))
#else
#define VXCD ((int)(blockIdx.x & 7))
#define VCU  ((int)(blockIdx.x >> 3))
#endif
typedef __attribute__((address_space(3))) unsigned lds_u32;
template <int N> DI void wait_vm() { asm volatile("s_waitcnt vmcnt(%0)" ::"n"(N) : "memory"); }
DI void block_barrier() { asm volatile("" ::: "memory"); __builtin_amdgcn_s_barrier(); asm volatile("" ::: "memory"); }
DI float dot2_self(u32 w, float c) {
  const bf16x2_t a = __builtin_bit_cast(bf16x2_t, w);
  return __builtin_amdgcn_fdot2_f32_bf16(a, a, c, false);
}

struct Seg { const u16* P; const u16* Q; int nk; };

template <int WP, int WQ, int PB, int QB, int NST, int SSQ>
struct GemmStream {
  static constexpr int TP = WP * PB * 32, TQ = WQ * QB * 32;
  static constexpr int NPP = TP / 64, NQP = TQ / 64, NPIECE = NPP + NQP;
  static constexpr int STAGE_BYTES = (TP + TQ) * 128;
  static constexpr int LDS_BYTES = NST * STAGE_BYTES;
  static constexpr int DEPTH = NST - 1;
  static constexpr int NSS = (SSQ == 1) ? QB : ((SSQ == 2) ? PB : 1);

  char* smem;
  int ldp, ldq;
  int st_issue, st_comp;
  int wave, wp, wq, l31, lh;
  unsigned p_off, q_off;
  unsigned lds_piece;

  DI void init(char* smem_, int ldp_, int ldq_) {
    smem = smem_; ldp = ldp_; ldq = ldq_;
    const int tid = opaque_tid(), lane = tid & 63;
    wave = tid >> 6; wp = wave / WQ; wq = wave % WQ; l31 = lane & 31; lh = lane >> 5;
    const int srow = 8 * wave + (lane >> 3);
    const int c = (lane & 7) ^ ((srow >> 1) & 7);
    p_off = (unsigned)(srow * ldp * 2 + c * 16);
    q_off = (unsigned)(srow * ldq * 2 + c * 16);
    lds_piece = (unsigned)(8 * wave * 128);
    st_issue = 0; st_comp = 0;
  }
  DI void issue(const Seg& s, int kt) {
    char* sb = smem + st_issue * STAGE_BYTES + lds_piece;
    const char* pg = (const char*)s.P + p_off + kt * 128;
    const char* qg = (const char*)s.Q + q_off + kt * 128;
#pragma unroll
    for (int i = 0; i < NPP; ++i)
      __builtin_amdgcn_global_load_lds((const unsigned*)(pg + (size_t)i * 64 * ldp * 2), (lds_u32*)(sb + i * 64 * 128), 16, 0, 0);
#pragma unroll
    for (int i = 0; i < NQP; ++i)
      __builtin_amdgcn_global_load_lds((const unsigned*)(qg + (size_t)i * 64 * ldq * 2), (lds_u32*)(sb + TP * 128 + i * 64 * 128), 16, 0, 0);
    st_issue = (st_issue + 1 == NST) ? 0 : st_issue + 1;
  }
  DI void load_frags(const char* sb, int ks, bf16x8 (&pf)[PB], bf16x8 (&qf)[QB]) {
#pragma unroll
    for (int pb = 0; pb < PB; ++pb) {
      const int r = wp * PB * 32 + pb * 32 + l31;
      pf[pb] = *(const bf16x8*)(sb + r * 128 + (((ks * 2 + lh) ^ ((r >> 1) & 7)) << 4));
    }
#pragma unroll
    for (int qb = 0; qb < QB; ++qb) {
      const int r = wq * QB * 32 + qb * 32 + l31;
      qf[qb] = *(const bf16x8*)(sb + TP * 128 + r * 128 + (((ks * 2 + lh) ^ ((r >> 1) & 7)) << 4));
    }
  }
  DI void compute(f32x16 (&acc)[PB][QB], float (&ss)[NSS]) {
    const char* sb = smem + st_comp * STAGE_BYTES;
#pragma unroll
    for (int ks = 0; ks < 4; ++ks) {
      bf16x8 pf[PB], qf[QB];
      load_frags(sb, ks, pf, qf);
#pragma unroll
      for (int pb = 0; pb < PB; ++pb)
#pragma unroll
        for (int qb = 0; qb < QB; ++qb) acc[pb][qb] = MFMA32(pf[pb], qf[qb], acc[pb][qb]);
      if (SSQ == 1) {
#pragma unroll
        for (int qb = 0; qb < QB; ++qb) {
          const uint4 w = __builtin_bit_cast(uint4, qf[qb]);
          ss[qb] = dot2_self(w.x, ss[qb]); ss[qb] = dot2_self(w.y, ss[qb]); ss[qb] = dot2_self(w.z, ss[qb]); ss[qb] = dot2_self(w.w, ss[qb]);
        }
      } else if (SSQ == 2) {
#pragma unroll
        for (int pb = 0; pb < PB; ++pb) {
          const uint4 w = __builtin_bit_cast(uint4, pf[pb]);
          ss[pb] = dot2_self(w.x, ss[pb]); ss[pb] = dot2_self(w.y, ss[pb]); ss[pb] = dot2_self(w.z, ss[pb]); ss[pb] = dot2_self(w.w, ss[pb]);
        }
      }
    }
    st_comp = (st_comp + 1 == NST) ? 0 : st_comp + 1;
  }
  DI void prologue(const Seg& s) {
#pragma unroll
    for (int d = 0; d < DEPTH; ++d) issue(s, d);
  }
  template <int MODE = 0>
  DI void run(f32x16 (&acc)[PB][QB], float (&ss)[NSS], const Seg& cur, const Seg& nxt) {
#pragma unroll
    for (int i = 0; i < NSS; ++i) ss[i] = 0.f;
    const int nk = cur.nk;
#pragma unroll 1
    for (int kt = 0; kt < nk; ++kt) {
      wait_vm<(DEPTH - 1) * NPIECE>();
      block_barrier();
      if (kt + DEPTH < nk) {
        if (MODE != 3) issue(cur, kt + DEPTH); else { issue(nxt, 0); }
      } else issue(nxt, kt + DEPTH - nk);
      if (MODE != 2) compute(acc, ss); else st_comp = (st_comp + 1 == NST) ? 0 : st_comp + 1;
    }
#pragma unroll
    for (int i = 0; i < NSS; ++i) ss[i] += shfl_xor_f(ss[i], 32);
  }
  DI void drain() {
    wait_vm<0>();
    block_barrier();
    st_issue = 0; st_comp = 0;
  }
};

template <int PB, int QB>
DI void zero_acc(f32x16 (&acc)[PB][QB]) {
#pragma unroll
  for (int a = 0; a < PB; ++a)
#pragma unroll
    for (int b = 0; b < QB; ++b)
#pragma unroll
      for (int r = 0; r < 16; ++r) acc[a][b][r] = 0.f;
}
DI void prep_transpose_tile(u16* __restrict__ dst, const float* __restrict__ src, const float* __restrict__ gain,
                            int N, int K, int tn, int tk, int n_scaled, float nscale, char* smem) {
  float* tile = (float*)smem;
  const int tid = threadIdx.x;
  const int c = tid & 63, r0 = tid >> 6;
#pragma unroll
  for (int i = 0; i < 8; ++i) {
    const int kr = r0 + i * 8, k = tk * 64 + kr, n = tn * 64 + c;
    float v = 0.f;
    if (n < N) v = src[(size_t)k * N + n] * (gain ? gain[k] : 1.f);
    tile[kr * 65 + c] = v;
  }
  __syncthreads();
#pragma unroll
  for (int i = 0; i < 8; ++i) {
    const int nr = r0 + i * 8, n = tn * 64 + nr, k = tk * 64 + c;
    float v = tile[c * 65 + nr];
    if (n < n_scaled) v *= nscale;
    dst[(size_t)n * K + k] = f2bf(v);
  }
  __syncthreads();
}

DI void phase_prep(const Params& p, char* smem) {
  const int tid = threadIdx.x;
  const size_t gtid = (size_t)blockIdx.x * NTHREADS + tid, gstride = (size_t)gridDim.x * NTHREADS;
  char* ws = p.ws;
  {
    const int n0 = 36 * 16, n1 = n0 + 12 * 6, n2 = n1 + 16 * 4, n3 = n2 + 16 * 16, n4 = n3 + 32 * 16;
    for (int w = blockIdx.x; w < n4; w += gridDim.x) {
      if (w < n0) {
        prep_transpose_tile((u16*)(ws + WS_WINT), p.w_in, p.attn_norm, INW, 1024, w / 16, w % 16, 512, 0.125f * 1.4426950408889634f, smem);
      } else if (w < n1) {
        const int v = w - n0; prep_transpose_tile((u16*)(ws + WS_WUQT), p.w_uq, p.cq_norm, 768, 384, v / 6, v % 6, 0, 1.f, smem);
      } else if (w < n2) {
        const int v = w - n1; prep_transpose_tile((u16*)(ws + WS_WUKVT), p.w_ukv, p.ckv_norm, 1024, 256, v / 4, v % 4, 0, 1.f, smem);
      } else if (w < n3) {
        const int v = w - n2; const int tk = v % 16;
        prep_transpose_tile((u16*)(ws + WS_WOT), p.w_o, (tk < 8) ? p.sb_out_norm : (p.mla_out_norm - 512), 1024, 1024, v / 16, tk, 0, 1.f, smem);
      } else {
        const int v = w - n3; prep_transpose_tile((u16*)(ws + WS_WPQT), p.peer_wq, p.ffn_norm, 2048, 1024, v / 16, v % 16, 0, 1.f, smem);
      }
    }
  }
  {
    u16* dst = (u16*)(ws + WS_SUBK);
    for (size_t i = gtid; i < 2ull * 8 * 128 * 128; i += gstride) {
      const int pp = (int)(i & 127);
      const int d = (pp & ~15) | swap23(pp & 15);
      dst[i] = f2bf(p.peer_sk[(i & ~127ull) | d]);
    }
  }
  {
    const int lane = tid & 63;
    const int gw = blockIdx.x * 8 + (tid >> 6), nw = gridDim.x * 8;
    float* rx = (float*)(ws + WS_RX);
    for (int row = gw; row < NTOK; row += nw) {
      const float4* src = (const float4*)(p.x + (size_t)row * 1024);
      uint2* dst = (uint2*)(ws + WS_XB + (size_t)row * 2048);
      float ss = 0.f;
#pragma unroll
      for (int i = 0; i < 4; ++i) {
        const float4 a = src[lane + 64 * i];
        ss += a.x * a.x + a.y * a.y + a.z * a.z + a.w * a.w;
        dst[lane + 64 * i] = make_uint2(pk_bf16(a.x, a.y), pk_bf16(a.z, a.w));
      }
      ss += shfl_xor_f(ss, 32); ss += shfl_xor_f(ss, 16); ss += shfl_xor_f(ss, 8); ss += shfl_xor_f(ss, 4); ss += shfl_xor_f(ss, 2); ss += shfl_xor_f(ss, 1);
      if (lane == 0) rx[row] = rsqrtf(ss * (1.f / 1024.f) + 1e-6f);
    }
  }
  {
    const int lane = tid & 63;
    const int gw = blockIdx.x * 8 + (tid >> 6), nw = gridDim.x * 8;
    const float4* g4 = (const float4*)p.ffn_norm;
    for (int row = gw; row < 2 * 16384; row += nw) {
      const bool isv = row >= 16384;
      const int e = row & 16383;
      const float4* src = (const float4*)((isv ? p.peer_v : p.peer_u) + (size_t)e * 1024);
      float4 v[4];
      float m = 0.f;
#pragma unroll
      for (int i = 0; i < 4; ++i) {
        v[i] = src[lane + 64 * i];
        if (!isv) { const float4 g = g4[lane + 64 * i]; v[i].x *= g.x; v[i].y *= g.y; v[i].z *= g.z; v[i].w *= g.w; }
        m = fmaxf(m, fmaxf(fmaxf(fabsf(v[i].x), fabsf(v[i].y)), fmaxf(fabsf(v[i].z), fabsf(v[i].w))));
      }
      m = fmaxf(m, shfl_xor_f(m, 32)); m = fmaxf(m, shfl_xor_f(m, 16)); m = fmaxf(m, shfl_xor_f(m, 8));
      m = fmaxf(m, shfl_xor_f(m, 4)); m = fmaxf(m, shfl_xor_f(m, 2)); m = fmaxf(m, shfl_xor_f(m, 1));
      const float sc = (m > 0.f) ? 448.f / m : 1.f;
      u32* dst = (u32*)(ws + (isv ? WS_VB : WS_UB) + (size_t)e * 1024);
#pragma unroll
      for (int i = 0; i < 4; ++i) {
        int w = 0;
        w = __builtin_amdgcn_cvt_pk_fp8_f32(v[i].x * sc, v[i].y * sc, w, false);
        w = __builtin_amdgcn_cvt_pk_fp8_f32(v[i].z * sc, v[i].w * sc, w, true);
        dst[lane + 64 * i] = (u32)w;
      }
      if (lane == 0) ((float*)(ws + (isv ? WS_VSC : WS_USC)))[e] = (m > 0.f) ? m * (1.f / 448.f) : 1.f;
    }
  }
}

typedef GemmStream<2, 4, 2, 2, 3, 0> G1;
DI void phase_inproj(const Params& p, char* smem) {
  char* ws = p.ws;
  const int tid = opaque_tid(), lane = tid & 63, wave = tid >> 6;
  const int wp = wave / 4, wq = wave % 4, l31 = lane & 31, lh = lane >> 5;
  const int xcd = VXCD, cu = VCU, ncu = gridDim.x >> 3;
  G1 gs; gs.init(smem, 1024, 1024);
  auto tile_nt = [&](int w) { return (w % 144) / 8; };
  auto tile_tt = [&](int w) { return ((w / 144) * 8 + (w % 8)) * 8 + xcd; };
  auto seg = [&](int w) { Seg s; s.P = (const u16*)(ws + WS_WINT) + (size_t)tile_nt(w) * 128 * 1024; s.Q = (const u16*)(ws + WS_XB) + (size_t)tile_tt(w) * 256 * 1024; s.nk = 16; return s; };
  Seg cur = seg(cu);
  gs.prologue(cur);
  for (int w = cu; w < 32 * 18; w += ncu) {
    const int tt = tile_tt(w), nt = tile_nt(w);
    const Seg nxt = (w + ncu < 32 * 18) ? seg(w + ncu) : cur;
    f32x16 acc[2][2];
    float ssq[1];
    zero_acc(acc);
#if defined(P1_PROBE)
    {
      f32x16 dacc[2][2]; float dss[1];
      zero_acc(dacc);
      gs.run<P1_PROBE == 1 ? 0 : P1_PROBE>(dacc, dss, cur, cur);
#pragma unroll
      for (int a = 0; a < 2; ++a)
#pragma unroll
        for (int b = 0; b < 2; ++b)
#pragma unroll
          for (int r = 0; r < 16; ++r) asm volatile("" ::"v"(dacc[a][b][r]));
    }
#endif
    gs.run(acc, ssq, cur, nxt);
    cur = nxt;
#pragma unroll
    for (int qb = 0; qb < 2; ++qb) {
      const int tl = wq * 64 + qb * 32 + l31;
      const int t = tt * 256 + tl;
      const float rt = ((const float*)(ws + WS_RX))[t];
#pragma unroll
      for (int pb = 0; pb < 2; ++pb) {
        const int nb = nt * 128 + wp * 64 + pb * 32;
        if (nb >= INW) continue;
        if (nb < 1024) {
          u16* dst = (u16*)(ws + (nb < 512 ? WS_SBQ : WS_SBK)) + (size_t)t * 512 + (nb & 511);
#pragma unroll
          for (int g = 0; g < 4; ++g) {
            const f32x16& a = acc[pb][qb];
            uint2 v = make_uint2(pk_bf16(a[4 * g] * rt, a[4 * g + 1] * rt), pk_bf16(a[4 * g + 2] * rt, a[4 * g + 3] * rt));
            *(uint2*)(dst + 8 * g + 4 * lh) = v;
          }
        } else if (nb < 1536) {
          const int hd = (nb - 1024);
          const int b = t >> 12, s = t & 4095;
          const int sp = (s & ~15) | swap23(s & 15);
          u16* dst = (u16*)(ws + WS_SBVT) + ((size_t)b * 512 + hd) * 4096 + sp;
#pragma unroll
          for (int r = 0; r < 16; ++r) dst[(size_t)crow(r, lh) * 4096] = f2bf(acc[pb][qb][r] * rt);
        } else if (nb < 1920) {
          u16* dst = (u16*)(ws + WS_CQ) + (size_t)t * 384 + (nb - 1536);
#pragma unroll
          for (int g = 0; g < 4; ++g) {
            const f32x16& a = acc[pb][qb];
            uint2 v = make_uint2(pk_bf16(a[4 * g] * rt, a[4 * g + 1] * rt), pk_bf16(a[4 * g + 2] * rt, a[4 * g + 3] * rt));
            *(uint2*)(dst + 8 * g + 4 * lh) = v;
          }
        } else if (nb < 2176) {
          u16* dst = (u16*)(ws + WS_CKV) + (size_t)t * 256 + (nb - 1920);
#pragma unroll
          for (int g = 0; g < 4; ++g) {
            const f32x16& a = acc[pb][qb];
            uint2 v = make_uint2(pk_bf16(a[4 * g] * rt, a[4 * g + 1] * rt), pk_bf16(a[4 * g + 2] * rt, a[4 * g + 3] * rt));
            *(uint2*)(dst + 8 * g + 4 * lh) = v;
          }
        } else {
          float* dst = (float*)(ws + WS_KPE) + (size_t)t * 32;
#pragma unroll
          for (int g = 0; g < 4; ++g) {
            const f32x16& a = acc[pb][qb];
            *(float4*)(dst + 8 * g + 4 * lh) = make_float4(a[4 * g] * rt, a[4 * g + 1] * rt, a[4 * g + 2] * rt, a[4 * g + 3] * rt);
          }
        }
      }
    }
  }
  gs.drain();
}
DI float rope_invf(int i0, int lh) {
  constexpr float C[16] = {1.0f, 0.5623413251903491f, 0.31622776601683794f, 0.17782794100389228f, 0.1f, 0.05623413251903491f,
                           0.03162277660168379f, 0.01778279410038923f, 0.01f, 0.005623413251903491f, 0.0031622776601683794f,
                           0.0017782794100389228f, 0.001f, 0.0005623413251903491f, 0.00031622776601683794f, 0.00017782794100389228f};
  return lh ? C[i0 + 4] : C[i0];
}
DI void sincos_turns(float ang, float& s, float& c) {
  float tr = ang * 0.15915494309189535f;
  tr = tr - floorf(tr);
  s = __builtin_amdgcn_sinf(tr);
  c = __builtin_amdgcn_cosf(tr);
}

typedef GemmStream<2, 4, 3, 1, 3, 1> G2Q;
typedef GemmStream<2, 4, 4, 1, 3, 1> G2KV;

DI void mla_q_tile(const Params& p, G2Q& gs, const Seg& cur, const Seg& nxt, int tt, int nt) {
  char* ws = p.ws;
  const int tid = opaque_tid(), lane = tid & 63, wave = tid >> 6;
  const int wp = wave / 4, wq = wave % 4, l31 = lane & 31, lh = lane >> 5;
  float ssq[1];
  f32x16 acc[3][1];
  zero_acc(acc);
  gs.run(acc, ssq, cur, nxt);
  const int hd = nt * 2 + wp;
  const float qscale = 0.10206207261596577f * 1.4426950408889634f;
#pragma unroll
  for (int qb = 0; qb < 1; ++qb) {
    const int tl = wq * 32 + l31;
    const int t = tt * 128 + tl;
    const float rc = rsqrtf(ssq[0] * (1.f / 384.f) + 1e-6f);
    float ss = 0.f;
#pragma unroll
    for (int pb = 0; pb < 3; ++pb)
#pragma unroll
      for (int r = 0; r < 16; ++r) { const float v = acc[pb][qb][r] * rc; acc[pb][qb][r] = v; ss += v * v; }
    ss += shfl_xor_f(ss, 32);
    const float rq = rsqrtf(ss * (1.f / 96.f) + 1e-6f) ;
#pragma unroll
    for (int pb = 0; pb < 3; ++pb)
#pragma unroll
      for (int g = 0; g < 4; ++g) {
        const float4 gn = *(const float4*)(p.q_norm + pb * 32 + 8 * g + 4 * lh);
        acc[pb][qb][4 * g] *= rq * gn.x; acc[pb][qb][4 * g + 1] *= rq * gn.y; acc[pb][qb][4 * g + 2] *= rq * gn.z; acc[pb][qb][4 * g + 3] *= rq * gn.w;
      }
    const float posf = (float)p.pos[t];
#pragma unroll
    for (int r = 0; r < 8; ++r) {
      const int i0 = (r & 3) + 8 * (r >> 2);
      float s, c; sincos_turns(posf * rope_invf(i0, lh), s, c);
      const float x1 = acc[2][qb][r], x2 = acc[2][qb][r + 8];
      acc[2][qb][r] = x1 * c - x2 * s;
      acc[2][qb][r + 8] = x1 * s + x2 * c;
    }
    const int b = t >> 12, sidx = t & 4095;
    u16* dst = (u16*)(ws + WS_MQ) + ((size_t)(b * 8 + hd) * 4096 + sidx) * 96;
#pragma unroll
    for (int pb = 0; pb < 3; ++pb)
#pragma unroll
      for (int g = 0; g < 4; ++g) {
        const f32x16& a = acc[pb][qb];
        *(uint2*)(dst + pb * 32 + 8 * g + 4 * lh) = make_uint2(pk_bf16(a[4 * g] * qscale, a[4 * g + 1] * qscale), pk_bf16(a[4 * g + 2] * qscale, a[4 * g + 3] * qscale));
      }
  }
}

DI void mla_kv_tile(const Params& p, G2KV& gs, const Seg& cur, const Seg& nxt, int tt, int nt) {
  char* ws = p.ws;
  const int tid = opaque_tid(), lane = tid & 63, wave = tid >> 6;
  const int wp = wave / 4, wq = wave % 4, l31 = lane & 31, lh = lane >> 5;
  float ssq[1];
  f32x16 acc[4][1];
  zero_acc(acc);
  gs.run(acc, ssq, cur, nxt);
  const int hd = nt * 2 + wp;
#pragma unroll
  for (int qb = 0; qb < 1; ++qb) {
    const int tl = wq * 32 + l31;
    const int t = tt * 128 + tl;
    const float rkv = rsqrtf(ssq[0] * (1.f / 256.f) + 1e-6f);
    float kp[16];
    const float* kpe = (const float*)(ws + WS_KPE) + (size_t)t * 32;
#pragma unroll
    for (int g = 0; g < 4; ++g) {
      const float4 v = *(const float4*)(kpe + 8 * g + 4 * lh);
      kp[4 * g] = v.x; kp[4 * g + 1] = v.y; kp[4 * g + 2] = v.z; kp[4 * g + 3] = v.w;
    }
    float ss = 0.f;
#pragma unroll
    for (int pb = 0; pb < 2; ++pb)
#pragma unroll
      for (int r = 0; r < 16; ++r) { const float v = acc[pb][qb][r] * rkv; acc[pb][qb][r] = v; ss += v * v; }
#pragma unroll
    for (int r = 0; r < 16; ++r) ss += kp[r] * kp[r];
    ss += shfl_xor_f(ss, 32);
    const float rk = rsqrtf(ss * (1.f / 96.f) + 1e-6f);
#pragma unroll
    for (int pb = 0; pb < 2; ++pb)
#pragma unroll
      for (int g = 0; g < 4; ++g) {
        const float4 gn = *(const float4*)(p.k_norm + pb * 32 + 8 * g + 4 * lh);
        acc[pb][qb][4 * g] *= rk * gn.x; acc[pb][qb][4 * g + 1] *= rk * gn.y; acc[pb][qb][4 * g + 2] *= rk * gn.z; acc[pb][qb][4 * g + 3] *= rk * gn.w;
      }
#pragma unroll
    for (int g = 0; g < 4; ++g) {
      const float4 gn = *(const float4*)(p.k_norm + 64 + 8 * g + 4 * lh);
      kp[4 * g] *= rk * gn.x; kp[4 * g + 1] *= rk * gn.y; kp[4 * g + 2] *= rk * gn.z; kp[4 * g + 3] *= rk * gn.w;
    }
    const float posf = (float)p.pos[t];
#pragma unroll
    for (int r = 0; r < 8; ++r) {
      const int i0 = (r & 3) + 8 * (r >> 2);
      float s, c; sincos_turns(posf * rope_invf(i0, lh), s, c);
      const float x1 = kp[r], x2 = kp[r + 8];
      kp[r] = x1 * c - x2 * s;
      kp[r + 8] = x1 * s + x2 * c;
    }
    const int b = t >> 12, sidx = t & 4095;
    u16* dst = (u16*)(ws + WS_MK) + ((size_t)(b * 8 + hd) * 4096 + sidx) * 96;
#pragma unroll
    for (int pb = 0; pb < 2; ++pb)
#pragma unroll
      for (int g = 0; g < 4; ++g) {
        const f32x16& a = acc[pb][qb];
        *(uint2*)(dst + pb * 32 + 8 * g + 4 * lh) = make_uint2(pk_bf16(a[4 * g], a[4 * g + 1]), pk_bf16(a[4 * g + 2], a[4 * g + 3]));
      }
#pragma unroll
    for (int g = 0; g < 4; ++g)
      *(uint2*)(dst + 64 + 8 * g + 4 * lh) = make_uint2(pk_bf16(kp[4 * g], kp[4 * g + 1]), pk_bf16(kp[4 * g + 2], kp[4 * g + 3]));
    const int sp = (sidx & ~15) | swap23(sidx & 15);
    u16* dv = (u16*)(ws + WS_MVT) + ((size_t)(b * 8 + hd) * 64) * 4096 + sp;
#pragma unroll
    for (int pb = 2; pb < 4; ++pb)
#pragma unroll
      for (int r = 0; r < 16; ++r) dv[(size_t)((pb - 2) * 32 + crow(r, lh)) * 4096] = f2bf(acc[pb][qb][r] * rkv);
  }
}

DI void phase_mlaproj(const Params& p, char* smem) {
  char* ws = p.ws;
  const int xcd = VXCD, cu = VCU, ncu = gridDim.x >> 3;
  {
    G2Q gs; gs.init(smem, 384, 384);
    auto seg = [&](int w) { Seg s; s.P = (const u16*)(ws + WS_WUQT) + (size_t)(w % 4) * 192 * 384; s.Q = (const u16*)(ws + WS_CQ) + (size_t)((w / 4) * 8 + xcd) * 128 * 384; s.nk = 6; return s; };
    Seg cur = seg(cu);
    gs.prologue(cur);
    for (int w = cu; w < 64 * 4; w += ncu) {
      const Seg nxt = (w + ncu < 64 * 4) ? seg(w + ncu) : cur;
      mla_q_tile(p, gs, cur, nxt, (w / 4) * 8 + xcd, w % 4);
      cur = nxt;
    }
    gs.drain();
  }
  {
    G2KV gs; gs.init(smem, 256, 256);
    auto seg = [&](int w) { Seg s; s.P = (const u16*)(ws + WS_WUKVT) + (size_t)(w % 4) * 256 * 256; s.Q = (const u16*)(ws + WS_CKV) + (size_t)((w / 4) * 8 + xcd) * 128 * 256; s.nk = 4; return s; };
    Seg cur = seg(cu);
    gs.prologue(cur);
    for (int w = cu; w < 64 * 4; w += ncu) {
      const Seg nxt = (w + ncu < 64 * 4) ? seg(w + ncu) : cur;
      mla_kv_tile(p, gs, cur, nxt, (w / 4) * 8 + xcd, w % 4);
      cur = nxt;
    }
    gs.drain();
  }
}
#define MLA_KROW 208
#define MLA_KBUF (64 * MLA_KROW)
#define MLA_VBUF (64 * 128)
DI void mla_attn_block(const Params& p, char* smem, int b, int hd, int qblk, float Mb) {
  char* ws = p.ws;
  const int tid = opaque_tid(), lane = tid & 63, wave = __builtin_amdgcn_readfirstlane(tid >> 6), l31 = lane & 31, lh = lane >> 5;
  const int q0 = qblk * 256;
  const int nkt = q0 / 64 + 4;
  const int my_nkt = q0 / 64 + (wave >> 1) + 1;
  const u16* Kg = (const u16*)(ws + WS_MK) + (size_t)(b * 8 + hd) * 4096 * 96;
  const u16* Vg = (const u16*)(ws + WS_MVT) + (size_t)(b * 8 + hd) * 64 * 4096;
  const u16* Qg = (const u16*)(ws + WS_MQ) + ((size_t)(b * 8 + hd) * 4096 + q0 + wave * 32 + l31) * 96;
  bf16x8 qf[6];
#pragma unroll
  for (int s = 0; s < 6; ++s) qf[s] = *(const bf16x8*)(Qg + 16 * s + 8 * lh);
  f32x16 o[2];
#pragma unroll
  for (int d = 0; d < 2; ++d)
#pragma unroll
    for (int r = 0; r < 16; ++r) o[d][r] = 0.f;
  float lsum = 0.f;

  const int kc0 = tid, kc1 = 512 + tid;
  const int k_l0 = (kc0 / 12) * MLA_KROW + (kc0 % 12) * 16, k_l1 = (kc1 / 12) * MLA_KROW + (kc1 % 12) * 16;
  const int vdv = tid >> 3, vcol = tid & 7;
  const int v_l = vdv * 128 + ((vcol ^ ((vdv >> 1) & 7)) << 4);
  char* Kb = smem;
  char* Vb = smem + 2 * MLA_KBUF;
  uint4 rkA0, rkA1, rvA, rkB0, rkB1, rvB;
  rkA1 = make_uint4(0, 0, 0, 0); rkB1 = make_uint4(0, 0, 0, 0);
  auto gload_k = [&](int kt, uint4& r0, uint4& r1) {
    const char* kb = (const char*)(Kg + (size_t)kt * 64 * 96);
    r0 = *(const uint4*)(kb + kc0 * 16);
    if (tid < 256) r1 = *(const uint4*)(kb + kc1 * 16);
  };
  auto gload_v = [&](int kt, uint4& r) { r = *(const uint4*)((const char*)(Vg + (size_t)vdv * 4096 + kt * 64) + vcol * 16); };
  auto sstore_k = [&](int buf, const uint4& r0, const uint4& r1) {
    char* kb = Kb + buf * MLA_KBUF;
    *(uint4*)(kb + k_l0) = r0;
    if (tid < 256) *(uint4*)(kb + k_l1) = r1;
  };
  auto sstore_v = [&](int buf, const uint4& r) { *(uint4*)(Vb + buf * MLA_VBUF + v_l) = r; };
  auto qk = [&](f32x16 (&st)[2], int buf) {
    const char* Ks = Kb + buf * MLA_KBUF;
#pragma unroll
    for (int kb = 0; kb < 2; ++kb)
#pragma unroll
      for (int r = 0; r < 16; ++r) st[kb][r] = -Mb;
#pragma unroll
    for (int s = 0; s < 6; ++s) {
#pragma unroll
      for (int kb = 0; kb < 2; ++kb) {
        const bf16x8 kf = *(const bf16x8*)(Ks + (kb * 32 + l31) * MLA_KROW + (2 * s + lh) * 16);
        st[kb] = MFMA32(kf, qf[s], st[kb]);
      }
    }
  };
  auto softmax_pv = [&](const f32x16 (&st)[2], int buf) {
    const char* Vs = Vb + buf * MLA_VBUF;
    bf16x8 pf[4];
#pragma unroll
    for (int kb = 0; kb < 2; ++kb) {
      float e[16];
#pragma unroll
      for (int r = 0; r < 16; ++r) { e[r] = __builtin_amdgcn_exp2f(st[kb][r]); lsum += e[r]; }
#pragma unroll
      for (int s2 = 0; s2 < 2; ++s2) {
        uint4 w = make_uint4(pk_bf16(e[8 * s2], e[8 * s2 + 1]), pk_bf16(e[8 * s2 + 2], e[8 * s2 + 3]),
                             pk_bf16(e[8 * s2 + 4], e[8 * s2 + 5]), pk_bf16(e[8 * s2 + 6], e[8 * s2 + 7]));
        pf[kb * 2 + s2] = __builtin_bit_cast(bf16x8, w);
      }
    }
#pragma unroll
    for (int ks = 0; ks < 4; ++ks) {
#pragma unroll
      for (int db = 0; db < 2; ++db) {
        const int r = db * 32 + l31;
        const bf16x8 vf = *(const bf16x8*)(Vs + r * 128 + (((2 * ks + lh) ^ ((r >> 1) & 7)) << 4));
        o[db] = MFMA32(vf, pf[ks], o[db]);
      }
    }
  };
  auto step = [&](int t, f32x16 (&s_cur)[2], f32x16 (&s_nxt)[2], uint4& xk0, uint4& xk1, uint4& xv, uint4& yk0, uint4& yk1, uint4& yv) {
    if (t + 3 < nkt) gload_k(t + 3, yk0, yk1);
    if (t + 2 < nkt) gload_v(t + 2, yv);
    if (t + 1 < my_nkt) qk(s_nxt, (t + 1) & 1);
    if (t < my_nkt) softmax_pv(s_cur, t & 1);
    if (t + 2 < nkt) sstore_k(t & 1, xk0, xk1);
    if (t + 1 < nkt) sstore_v((t + 1) & 1, xv);
    __syncthreads();
  };
  gload_k(0, rkA0, rkA1); gload_v(0, rvA); sstore_k(0, rkA0, rkA1); sstore_v(0, rvA);
  gload_k(1, rkA0, rkA1); sstore_k(1, rkA0, rkA1);
  gload_k(2, rkA0, rkA1); gload_v(1, rvA);
  __syncthreads();
  f32x16 sa[2], sb[2];
  qk(sa, 0);
  __syncthreads();
#pragma unroll 1
  for (int t = 0; t < nkt; t += 2) {
    step(t, sa, sb, rkA0, rkA1, rvA, rkB0, rkB1, rvB);
    step(t + 1, sb, sa, rkB0, rkB1, rvB, rkA0, rkA1, rvA);
  }
  lsum += shfl_xor_f(lsum, 32);
  const float inv = 1.f / lsum;
  const int tq = b * 4096 + q0 + wave * 32 + l31;
  u16* dst = (u16*)(ws + WS_MLAO) + (size_t)tq * 512 + hd * 64;
#pragma unroll
  for (int db = 0; db < 2; ++db)
#pragma unroll
    for (int g = 0; g < 4; ++g) {
      const f32x16& a = o[db];
      *(uint2*)(dst + db * 32 + 8 * g + 4 * lh) = make_uint2(pk_bf16(a[4 * g] * inv, a[4 * g + 1] * inv), pk_bf16(a[4 * g + 2] * inv, a[4 * g + 3] * inv));
    }
}

DI void sb_attn_wave(const Params& p, int b, int hd, int rg) {
  char* ws = p.ws;
  const int lane = threadIdx.x & 63, l31 = lane & 31, lh = lane >> 5;
  const int r0 = rg * 32;
  const u16* Qg = (const u16*)(ws + WS_SBQ) + ((size_t)(b * 4096 + r0 + l31)) * 512 + hd * 64 + 8 * lh;
  const u16* Kg = (const u16*)(ws + WS_SBK) + ((size_t)(b * 4096 + l31)) * 512 + hd * 64 + 8 * lh;
  const u16* Vg = (const u16*)(ws + WS_SBVT) + ((size_t)(b * 8 + hd) * 64 + l31) * 4096 + 8 * lh;
  bf16x8 qf[4];
#pragma unroll
  for (int s = 0; s < 4; ++s) qf[s] = *(const bf16x8*)(Qg + 16 * s);
  f32x16 o[2];
#pragma unroll
  for (int d = 0; d < 2; ++d)
#pragma unroll
    for (int r = 0; r < 16; ++r) o[d][r] = 0.f;
  float carry = 0.f;
  bf16x8 kf[4], vf[2][2], kfn[4], vfn[2][2];
  auto loadkv = [&](int k0, bf16x8 (&kk)[4], bf16x8 (&vv)[2][2]) {
#pragma unroll
    for (int s = 0; s < 4; ++s) kk[s] = *(const bf16x8*)(Kg + (size_t)k0 * 512 + 16 * s);
#pragma unroll
    for (int db = 0; db < 2; ++db)
#pragma unroll
      for (int s2 = 0; s2 < 2; ++s2) vv[db][s2] = *(const bf16x8*)(Vg + (size_t)db * 32 * 4096 + k0 + 16 * s2);
  };
  loadkv(r0, kf, vf);
  for (int k0 = r0; k0 >= 0; k0 -= 32) {
    const int kn = (k0 >= 32) ? k0 - 32 : 0;
    loadkv(kn, kfn, vfn);
    f32x16 z;
#pragma unroll
    for (int r = 0; r < 16; ++r) z[r] = 0.f;
#pragma unroll
    for (int s = 0; s < 4; ++s) z = MFMA32(kf[s], qf[s], z);
    const bool diag = (k0 == r0);
    float lf[16], ls[16];
#pragma unroll
    for (int r = 0; r < 16; ++r) {
      const float zz = z[r];
      const float tt = __builtin_amdgcn_logf(1.f + __builtin_amdgcn_exp2f(-fabsf(zz)));
      lf[r] = -fmaxf(zz, 0.f) - tt;
      ls[r] = fminf(zz, 0.f) - tt;
      const bool masked = diag && !(crow(r, lh) < l31);
      if (masked) { lf[r] = 0.f; ls[r] = -INFINITY; }
    }
    float gs[4], pg[4];
#pragma unroll
    for (int g = 0; g < 4; ++g) { gs[g] = (lf[4 * g] + lf[4 * g + 1]) + (lf[4 * g + 2] + lf[4 * g + 3]); pg[g] = shfl_xor_f(gs[g], 32); }
    float so[4], spi[4];
    so[3] = 0.f; so[2] = gs[3]; so[1] = gs[3] + gs[2]; so[0] = so[1] + gs[1];
    spi[3] = pg[3]; spi[2] = pg[3] + pg[2]; spi[1] = spi[2] + pg[1]; spi[0] = spi[1] + pg[0];
    f32x16 a;
#pragma unroll
    for (int g = 0; g < 4; ++g) {
      const float spx = (g < 3) ? spi[g + 1] : 0.f;
      float base = carry + so[g] + (lh ? spx : spi[g]);
      a[4 * g + 3] = __builtin_amdgcn_exp2f(ls[4 * g + 3] + base); base += lf[4 * g + 3];
      a[4 * g + 2] = __builtin_amdgcn_exp2f(ls[4 * g + 2] + base); base += lf[4 * g + 2];
      a[4 * g + 1] = __builtin_amdgcn_exp2f(ls[4 * g + 1] + base); base += lf[4 * g + 1];
      a[4 * g + 0] = __builtin_amdgcn_exp2f(ls[4 * g + 0] + base);
    }
    carry += so[0] + gs[0] + spi[0];
#pragma unroll
    for (int s2 = 0; s2 < 2; ++s2) {
      uint4 w = make_uint4(pk_bf16(a[8 * s2], a[8 * s2 + 1]), pk_bf16(a[8 * s2 + 2], a[8 * s2 + 3]),
                           pk_bf16(a[8 * s2 + 4], a[8 * s2 + 5]), pk_bf16(a[8 * s2 + 6], a[8 * s2 + 7]));
      const bf16x8 pf = __builtin_bit_cast(bf16x8, w);
#pragma unroll
      for (int db = 0; db < 2; ++db) o[db] = MFMA32(vf[db][s2], pf, o[db]);
    }
    if (__all(carry <= -151.f)) break;
#pragma unroll
    for (int s = 0; s < 4; ++s) kf[s] = kfn[s];
#pragma unroll
    for (int db = 0; db < 2; ++db)
#pragma unroll
      for (int s2 = 0; s2 < 2; ++s2) vf[db][s2] = vfn[db][s2];
  }
  const int t = b * 4096 + r0 + l31;
  u16* dst = (u16*)(ws + WS_SBO) + (size_t)t * 512 + hd * 64;
#pragma unroll
  for (int db = 0; db < 2; ++db)
#pragma unroll
    for (int g = 0; g < 4; ++g) {
      const f32x16& a = o[db];
      *(uint2*)(dst + db * 32 + 8 * g + 4 * lh) = make_uint2(pk_bf16(a[4 * g], a[4 * g + 1]), pk_bf16(a[4 * g + 2], a[4 * g + 3]));
    }
}

DI void phase_attn(const Params& p, char* smem) {
  const int xcd = VXCD, cu = VCU, ncu = gridDim.x >> 3;
  float gq = 0.f, gk = 0.f;
  for (int i = 0; i < 96; ++i) { gq = fmaxf(gq, fabsf(p.q_norm[i])); gk = fmaxf(gk, fabsf(p.k_norm[i])); }
  const float Mb = 9.797958971132712f * 1.4426950408889634f * gq * gk * 1.01f;
  for (int w = cu; w < 16 * 8; w += ncu) {
    const int bh = (w / 8) * 8 + xcd, c = w % 8;
    mla_attn_block(p, smem, bh >> 3, bh & 7, 15 - c, Mb);
    __syncthreads();
    mla_attn_block(p, smem, bh >> 3, bh & 7, c, Mb);
    __syncthreads();
  }
  const int wave = threadIdx.x >> 6;
#ifdef SB_TWICE
  for (int rep = 0; rep < 2; ++rep)
#endif
  for (int w = blockIdx.x; w < 256; w += gridDim.x) {
    const int bh = w >> 1, half = w & 1;
    for (int i = 0; i < 8; ++i) sb_attn_wave(p, bh >> 3, bh & 7, half * 64 + i * 8 + wave);
  }
}
template <int CTRL> DI float dpp_mov(float x) {
  return __uint_as_float(__builtin_amdgcn_update_dpp(0, __float_as_uint(x), CTRL, 0xf, 0xf, true));
}
typedef GemmStream<2, 4, 2, 2, 3, 2> G4;
DI void phase_outproj(const Params& p, char* smem) {
  char* ws = p.ws;
  const int tid = opaque_tid(), lane = tid & 63, wave = tid >> 6;
  const int wp = wave / 4, wq = wave % 4, l31 = lane & 31, lh = lane >> 5;
  const int xcd = VXCD, cu = VCU, ncu = gridDim.x >> 3;
  G4 gs; gs.init(smem, 512, 1024);
  auto seg = [&](int w2) { const int w = w2 >> 1, h = w2 & 1; Seg s; s.P = (const u16*)(ws + (h ? WS_MLAO : WS_SBO)) + (size_t)((w / 4) * 8 + xcd) * 128 * 512;
                           s.Q = (const u16*)(ws + WS_WOT) + (size_t)(w % 4) * 256 * 1024 + h * 512; s.nk = 8; return s; };
  Seg c0 = seg(2 * cu);
  gs.prologue(c0);
  for (int w = cu; w < 64 * 4; w += ncu) {
    const int tt = (w / 4) * 8 + xcd, nt = w % 4;
    const Seg c1 = seg(2 * w + 1);
    const Seg n0 = (w + ncu < 64 * 4) ? seg(2 * (w + ncu)) : c0;
    f32x16 acc0[2][2], acc1[2][2];
    float ss0[2], ss1[2];
    zero_acc(acc0); zero_acc(acc1);
    gs.run(acc0, ss0, c0, c1);
    gs.run(acc1, ss1, c1, n0);
    c0 = n0;
    const int q = lane & 3;
    const bool odd = (q & 1) != 0, hi = (q & 2) != 0;
#pragma unroll
    for (int pb = 0; pb < 2; ++pb) {
      const float r0 = rsqrtf(ss0[pb] * (1.f / 512.f) + 1e-6f), r1 = rsqrtf(ss1[pb] * (1.f / 512.f) + 1e-6f);
#pragma unroll
      for (int g = 0; g < 4; ++g) {
        float s0[4], s1[4];
#pragma unroll
        for (int i = 0; i < 4; ++i) { s0[i] = __shfl(r0, 8 * g + 4 * lh + i, 64); s1[i] = __shfl(r1, 8 * g + 4 * lh + i, 64); }
        const size_t t = (size_t)tt * 128 + wp * 64 + pb * 32 + 8 * g + 4 * lh + q;
#pragma unroll
        for (int qb = 0; qb < 2; ++qb) {
          float a[4];
#pragma unroll
          for (int i = 0; i < 4; ++i) a[i] = s0[i] * acc0[pb][qb][4 * g + i] + s1[i] * acc1[pb][qb][4 * g + i];
          const float t01 = dpp_mov<0xB1>(odd ? a[0] : a[1]), t23 = dpp_mov<0xB1>(odd ? a[2] : a[3]);
          const float b0 = odd ? t01 : a[0], b1 = odd ? a[1] : t01, b2 = odd ? t23 : a[2], b3 = odd ? a[3] : t23;
          const float u0 = dpp_mov<0x4E>(hi ? b0 : b2), u1 = dpp_mov<0x4E>(hi ? b1 : b3);
          const float c0 = hi ? u0 : b0, c1 = hi ? u1 : b1, c2 = hi ? b2 : u0, c3 = hi ? b3 : u1;
          const int n = nt * 256 + wq * 64 + qb * 32 + (l31 & ~3);
          const float4 xv = *(const float4*)(p.x + t * 1024 + n);
          const float4 o = make_float4(xv.x + c0, xv.y + c1, xv.z + c2, xv.w + c3);
          *(float4*)(p.out + t * 1024 + n) = o;
          *(uint2*)((u16*)(ws + WS_XB) + t * 1024 + n) = make_uint2(pk_bf16(o.x, o.y), pk_bf16(o.z, o.w));
        }
      }
    }
  }
  gs.drain();
}

DI int f2key(float f) { const int b = __float_as_int(f); return b ^ ((b >> 31) & 0x7fffffff); }
DI float key2f(int k) { return __int_as_float(k ^ ((k >> 31) & 0x7fffffff)); }
#define CE_D(a, b) { const int _mx = max(a, b), _mn = min(a, b); a = _mx; b = _mn; }
template <int N, int OFF>
DI void bitonic_sort_desc(int (&v)[64]) {
#pragma unroll
  for (int k = 2; k <= N; k <<= 1)
#pragma unroll
    for (int j = k >> 1; j > 0; j >>= 1)
#pragma unroll
      for (int i = 0; i < N; ++i) {
        const int l = i ^ j;
        if (l > i) {
          if ((i & k) == 0 || k == N) { CE_D(v[OFF + i], v[OFF + l]); } else { CE_D(v[OFF + l], v[OFF + i]); }
        }
      }
}
DI void bitonic_merge16_desc(int (&v)[16]) {
#pragma unroll
  for (int j = 8; j > 0; j >>= 1)
#pragma unroll
    for (int i = 0; i < 16; ++i) { const int l = i ^ j; if (l > i) { CE_D(v[i], v[l]); } }
}
DI void top16_of_64(int (&v)[64], int (&out)[16]) {
  bitonic_sort_desc<16, 0>(v); bitonic_sort_desc<16, 16>(v); bitonic_sort_desc<16, 32>(v); bitonic_sort_desc<16, 48>(v);
  int a[16], b[16];
#pragma unroll
  for (int i = 0; i < 16; ++i) { a[i] = max(v[i], v[31 - i]); b[i] = max(v[32 + i], v[63 - i]); }
  bitonic_merge16_desc(a); bitonic_merge16_desc(b);
#pragma unroll
  for (int i = 0; i < 16; ++i) out[i] = max(a[i], b[15 - i]);
  bitonic_merge16_desc(out);
}

typedef GemmStream<2, 4, 4, 2, 2, 1> G5;
#define P5_SUBK_OFF 0
#define P5_LIST_OFF 65536
DI void peer_query_tile(const Params& p, char* smem, int tt, int hd) {
  char* ws = p.ws;
  const int tid = opaque_tid(), lane = tid & 63, wave = tid >> 6;
  const int wp = wave / 4, wq = wave % 4, l31 = lane & 31, lh = lane >> 5;
  float ssq[2];
  f32x16 acc[4][2];
  zero_acc(acc);
  {
    G5 gs; gs.init(smem, 1024, 1024);
    Seg cur; cur.P = (const u16*)(ws + WS_WPQT) + (size_t)hd * 256 * 1024; cur.Q = (const u16*)(ws + WS_XB) + (size_t)tt * 256 * 1024; cur.nk = 16;
    gs.prologue(cur);
    gs.run(acc, ssq, cur, cur);
    gs.drain();
  }
  {
    const uint4* src0 = (const uint4*)((const u16*)(ws + WS_SUBK) + (size_t)(0 * 8 + hd) * 128 * 128);
    const uint4* src1 = (const uint4*)((const u16*)(ws + WS_SUBK) + (size_t)(1 * 8 + hd) * 128 * 128);
#pragma unroll
    for (int i = 0; i < 4; ++i) {
      const int ch = tid + i * 512;
      const int key = ch >> 4, cc = ch & 15;
      const int off = key * 256 + ((cc ^ (key & 15)) << 4);
      *(uint4*)(smem + P5_SUBK_OFF + off) = src0[ch];
      *(uint4*)(smem + P5_SUBK_OFF + 32768 + off) = src1[ch];
    }
  }
  __syncthreads();
  const char* sk = smem + P5_SUBK_OFF + wp * 32768;
  int* lists = (int*)(smem + P5_LIST_OFF);
  bf16x8 xf[2][8];
#pragma unroll
  for (int qb = 0; qb < 2; ++qb) {
    const float r2 = rsqrtf(ssq[qb] * (1.f / 1024.f) + 1e-6f);
#pragma unroll
    for (int pb = 0; pb < 4; ++pb)
#pragma unroll
      for (int s2 = 0; s2 < 2; ++s2) {
        const f32x16& a = acc[pb][qb];
        uint4 w = make_uint4(pk_bf16(a[8 * s2] * r2, a[8 * s2 + 1] * r2), pk_bf16(a[8 * s2 + 2] * r2, a[8 * s2 + 3] * r2),
                             pk_bf16(a[8 * s2 + 4] * r2, a[8 * s2 + 5] * r2), pk_bf16(a[8 * s2 + 6] * r2, a[8 * s2 + 7] * r2));
        xf[qb][pb * 2 + s2] = __builtin_bit_cast(bf16x8, w);
      }
  }
#pragma unroll
  for (int qb = 0; qb < 2; ++qb) {
    const int tl = wq * 64 + qb * 32 + l31;
    int keys[64];
#pragma unroll
    for (int kb = 0; kb < 4; ++kb) {
      f32x16 sc;
#pragma unroll
      for (int r = 0; r < 16; ++r) sc[r] = 0.f;
      const int key = kb * 32 + l31;
#pragma unroll
      for (int kk = 0; kk < 8; ++kk) {
        const bf16x8 af = *(const bf16x8*)(sk + key * 256 + (((2 * kk + lh) ^ (key & 15)) << 4));
        sc = MFMA32(af, xf[qb][kk], sc);
      }
#pragma unroll
      for (int r = 0; r < 16; ++r) {
        const int n = kb * 32 + crow(r, lh);
        keys[kb * 16 + r] = f2key(__int_as_float((__float_as_int(sc[r]) & ~127) | n));
      }
    }
    int top[16];
    top16_of_64(keys, top);
    int mrg[16];
#pragma unroll
    for (int i = 0; i < 16; ++i) mrg[i] = __shfl_xor(top[15 - i], 32, 64);
#pragma unroll
    for (int i = 0; i < 16; ++i) mrg[i] = max(mrg[i], top[i]);
    bitonic_merge16_desc(mrg);
    if (lh == 0) {
      int* dst = lists + (wp * 256 + tl) * 16;
#pragma unroll
      for (int g = 0; g < 4; ++g) *(int4*)(dst + 4 * g) = make_int4(mrg[4 * g], mrg[4 * g + 1], mrg[4 * g + 2], mrg[4 * g + 3]);
    }
  }
  __syncthreads();
  if (tid < 256) {
    const int* la = lists + tid * 16;
    const int* lb = lists + (256 + tid) * 16;
    float av[16], bv[16];
#pragma unroll
    for (int i = 0; i < 16; ++i) {
      av[i] = __int_as_float(__float_as_int(key2f(la[i])) & ~127);
      bv[i] = __int_as_float(__float_as_int(key2f(lb[i])) & ~127);
    }
    int cand[64];
    int nc = 0;
#pragma unroll
    for (int i = 0; i < 16; ++i)
#pragma unroll
      for (int j = 0; j < 16; ++j)
        if ((i + 1) * (j + 1) <= 16) {
          const float s = av[i] + bv[j];
          cand[nc] = f2key(__int_as_float((__float_as_int(s) & ~255) | (i * 16 + j)));
          ++nc;
        }
#pragma unroll
    for (int i = 50; i < 64; ++i) cand[i] = (int)0x80000000;
    int best[16];
    top16_of_64(cand, best);
    float sv[16], den = 0.f;
    int ex[16];
    const float smax = key2f(best[0]);
#pragma unroll
    for (int k = 0; k < 16; ++k) {
      const float s = key2f(best[k]);
      const int id = __float_as_int(s) & 255;
      const int n1 = __float_as_int(key2f(la[id >> 4])) & 127;
      const int n2 = __float_as_int(key2f(lb[id & 15])) & 127;
      ex[k] = n1 * 128 + n2;
      sv[k] = __expf(s - smax);
      den += sv[k];
    }
    const float inv = 1.f / den;
    const size_t t = (size_t)tt * 256 + tid;
    int* di = (int*)(ws + WS_IDX) + t * 128 + hd * 16;
    float* dg = (float*)(ws + WS_GATE) + t * 128 + hd * 16;
#pragma unroll
    for (int g = 0; g < 4; ++g) {
      *(int4*)(di + 4 * g) = make_int4(ex[4 * g], ex[4 * g + 1], ex[4 * g + 2], ex[4 * g + 3]);
      *(float4*)(dg + 4 * g) = make_float4(sv[4 * g] * inv, sv[4 * g + 1] * inv, sv[4 * g + 2] * inv, sv[4 * g + 3] * inv);
    }
  }
  __syncthreads();
}
DI void phase_peerq(const Params& p, char* smem) {
  const int xcd = VXCD, cu = VCU, ncu = gridDim.x >> 3;
  for (int w = cu; w < 32 * 8; w += ncu) peer_query_tile(p, smem, (w / 8) * 8 + xcd, w % 8);
}

DI float wave_sum(float v) {
  v += shfl_xor_f(v, 32); v += shfl_xor_f(v, 16); v += shfl_xor_f(v, 8); v += shfl_xor_f(v, 4); v += shfl_xor_f(v, 2); v += shfl_xor_f(v, 1);
  return v;
}
DI float reduce8(const float (&d)[8], int lane) {
  float r1[4], r2[2];
#pragma unroll
  for (int m = 0; m < 4; ++m) {
    auto r = __builtin_amdgcn_permlane32_swap(__float_as_uint(d[m]), __float_as_uint(d[m + 4]), false, false);
    r1[m] = __uint_as_float(r[0]) + __uint_as_float(r[1]);
  }
#pragma unroll
  for (int m = 0; m < 2; ++m) {
    auto r = __builtin_amdgcn_permlane16_swap(__float_as_uint(r1[m]), __float_as_uint(r1[m + 2]), false, false);
    r2[m] = __uint_as_float(r[0]) + __uint_as_float(r[1]);
  }
  const bool b3 = (lane & 8) != 0;
  const float keep = b3 ? r2[1] : r2[0], send = b3 ? r2[0] : r2[1];
  float s = keep + dpp_mov<0x128>(send);
  s += dpp_mov<0x141>(s);
  s += dpp_mov<0xB1>(s);
  s += dpp_mov<0x4E>(s);
  return s;
}
DI void dot_row(const uint4& row, const f32x2 (&x2)[8], float& d) {
  const u32 w[4] = {row.x, row.y, row.z, row.w};
  f32x2 a = {0.f, 0.f};
#pragma unroll
  for (int i = 0; i < 4; ++i) {
    a = x2[2 * i] * __builtin_amdgcn_cvt_pk_f32_fp8(w[i], false) + a;
    a = x2[2 * i + 1] * __builtin_amdgcn_cvt_pk_f32_fp8(w[i], true) + a;
  }
  d = a[0] + a[1];
}
DI void axpy_row(const uint4& row, float c, f32x2 (&acc)[8]) {
  const u32 w[4] = {row.x, row.y, row.z, row.w};
  const f32x2 cc = {c, c};
#pragma unroll
  for (int i = 0; i < 4; ++i) {
    acc[2 * i] = cc * __builtin_amdgcn_cvt_pk_f32_fp8(w[i], false) + acc[2 * i];
    acc[2 * i + 1] = cc * __builtin_amdgcn_cvt_pk_f32_fp8(w[i], true) + acc[2 * i + 1];
  }
}
#define P6_ENT_E 0
#define P6_ENT_C 2048
#define P6_ENT_G 4096
#define P6_CNT   6144
#define P6_WAVE_BYTES 6400
DI void phase_experts(const Params& p, char* smem) {
  char* ws = p.ws;
  const int lane = threadIdx.x & 63, wave = threadIdx.x >> 6;
  const int xcd = VXCD, cu = VCU, ncu = gridDim.x >> 3;
  const char* U8 = ws + WS_UB + lane * 16;
  const char* V8 = ws + WS_VB + lane * 16;
  const float* usc = (const float*)(ws + WS_USC);
  const float* vsc = (const float*)(ws + WS_VSC);
  char* wl = smem + wave * P6_WAVE_BYTES;
  u32* ent_e = (u32*)(wl + P6_ENT_E);
  float* ent_c = (float*)(wl + P6_ENT_C);
  float* ent_g = (float*)(wl + P6_ENT_G);
  int* cnt = (int*)(wl + P6_CNT);
  const int tok_per_round = ncu * 32;
  const int tok_per_xcd = NTOK / 8;
  const int jq = 128 * ((lane & 7) >> 1) + (lane & 1);
  const int jr = 128 * ((lane >> 3) >> 1) + ((lane >> 3) & 1);
#pragma unroll 1
  for (int rb = cu * 32; rb < tok_per_xcd; rb += tok_per_round) {
    const int t0 = xcd * tok_per_xcd + rb + wave * 4;
    f32x2 x2[4][8];
    float r2[4];
#pragma unroll
    for (int k = 0; k < 4; ++k) {
      const float* orow = p.out + (size_t)(t0 + k) * 1024 + 16 * lane;
      float ss = 0.f;
#pragma unroll
      for (int i = 0; i < 4; ++i) {
        const float4 a = *(const float4*)(orow + 4 * i);
        x2[k][2 * i] = f32x2{a.x, a.y}; x2[k][2 * i + 1] = f32x2{a.z, a.w};
        ss += a.x * a.x + a.y * a.y + a.z * a.z + a.w * a.w;
      }
      ss = wave_sum(ss);
      r2[k] = rsqrtf(ss * (1.f / 1024.f) + 1e-6f);
    }
    cnt[lane] = 0;
    {
      int e_[4][2], pos_[4][2];
      float c_[4][2], g_[4][2];
#pragma unroll
      for (int k = 0; k < 4; ++k) {
        const int* idx = (const int*)(ws + WS_IDX) + (size_t)(t0 + k) * 128;
        const float* gate = (const float*)(ws + WS_GATE) + (size_t)(t0 + k) * 128;
#pragma unroll
        for (int h = 0; h < 2; ++h) {
          const int e = idx[64 * h + lane];
          e_[k][h] = e;
          c_[k][h] = r2[k] * usc[e];
          g_[k][h] = gate[64 * h + lane] * vsc[e];
          pos_[k][h] = atomicAdd(&cnt[k * 16 + (e >> 10)], 1);
        }
      }
      const int c = cnt[lane];
      int incl = c;
#pragma unroll
      for (int d = 1; d < 64; d <<= 1) { const int v = __shfl_up(incl, d, 64); if (lane >= d) incl += v; }
      cnt[lane] = incl - c;
#pragma unroll
      for (int k = 0; k < 4; ++k)
#pragma unroll
        for (int h = 0; h < 2; ++h) {
          const int e = e_[k][h];
          const int q = cnt[k * 16 + (e >> 10)] + pos_[k][h];
          ent_e[q] = (u32)e;
          ent_c[q] = c_[k][h];
          ent_g[q] = g_[k][h];
        }
    }
    uint4 ra[8], rb8[8];
    auto issue = [&](const char* tab, int g, uint4 (&rr)[8]) {
      const u32 ev = ent_e[jq + 2 * g];
#pragma unroll
      for (int j = 0; j < 8; ++j) {
        const u32 e = (u32)__builtin_amdgcn_readlane((int)ev, j);
        rr[j] = *(const uint4*)(tab + (size_t)e * 1024);
      }
    };
    auto compute_u = [&](int g, const uint4 (&rr)[8]) {
      float d[8];
#pragma unroll
      for (int j = 0; j < 8; ++j) dot_row(rr[j], x2[j >> 1], d[j]);
      const float tot = reduce8(d, lane);
      const int q = jr + 2 * g;
      const float pre = tot * ent_c[q];
      const float cf = ent_g[q] * 0.5f * pre * (1.f + erff(pre * 0.7071067811865476f));
      if ((lane & 7) == 0) ent_c[q] = cf;
    };
    issue(U8, 0, ra);
#pragma unroll 1
    for (int g = 0; g < 64; g += 2) {
      issue(U8, g + 1, rb8);
      compute_u(g, ra);
      issue(U8, (g + 2 < 64) ? g + 2 : 63, ra);
      compute_u(g + 1, rb8);
      if ((g & 6) == 6) __syncthreads();
    }
    f32x2 acc[4][8];
#pragma unroll
    for (int k = 0; k < 4; ++k)
#pragma unroll
      for (int i = 0; i < 8; ++i) acc[k][i] = f32x2{0.f, 0.f};
    auto compute_v = [&](int g, const uint4 (&rr)[8]) {
      const float cl = ent_c[jq + 2 * g];
#pragma unroll
      for (int j = 0; j < 8; ++j) axpy_row(rr[j], __int_as_float(__builtin_amdgcn_readlane(__float_as_int(cl), j)), acc[j >> 1]);
    };
    issue(V8, 0, ra);
#pragma unroll 1
    for (int g = 0; g < 64; g += 2) {
      issue(V8, g + 1, rb8);
      compute_v(g, ra);
      issue(V8, (g + 2 < 64) ? g + 2 : 63, ra);
      compute_v(g + 1, rb8);
      if ((g & 6) == 6) __syncthreads();
    }
#pragma unroll
    for (int k = 0; k < 4; ++k) {
      float* orow = p.out + (size_t)(t0 + k) * 1024 + 16 * lane;
#pragma unroll
      for (int i = 0; i < 4; ++i) {
        const float4 a = *(const float4*)(orow + 4 * i);
        *(float4*)(orow + 4 * i) = make_float4(a.x + acc[k][2 * i][0], a.y + acc[k][2 * i][1], a.z + acc[k][2 * i + 1][0], a.w + acc[k][2 * i + 1][1]);
      }
    }
  }
}

DI void phase_experts_simple(const Params& p, char* smem) {
  char* ws = p.ws;
  const int lane = threadIdx.x & 63, wave = threadIdx.x >> 6;
  const int gw = blockIdx.x * 8 + wave, nw = gridDim.x * 8;
  const char* U8 = ws + WS_UB + lane * 16;
  const char* V8 = ws + WS_VB + lane * 16;
  const float* usc = (const float*)(ws + WS_USC);
  const float* vsc = (const float*)(ws + WS_VSC);
#pragma unroll 1
  for (int t = gw; t < NTOK; t += nw) {
    f32x2 x2[8], acc[8];
    float* orow = p.out + (size_t)t * 1024 + 16 * lane;
#pragma unroll
    for (int i = 0; i < 4; ++i) {
      const float4 a = *(const float4*)(orow + 4 * i);
      x2[2 * i] = f32x2{a.x, a.y}; x2[2 * i + 1] = f32x2{a.z, a.w};
    }
    float ss = 0.f;
#pragma unroll
    for (int i = 0; i < 8; ++i) { ss += x2[i][0] * x2[i][0] + x2[i][1] * x2[i][1]; acc[i] = f32x2{0.f, 0.f}; }
    ss = wave_sum(ss);
    const float r2 = rsqrtf(ss * (1.f / 1024.f) + 1e-6f);
    const int* idx = (const int*)(ws + WS_IDX) + (size_t)t * 128;
    const float* gate = (const float*)(ws + WS_GATE) + (size_t)t * 128;
#pragma unroll 4
    for (int k = 0; k < 128; ++k) {
      const int e = idx[k];
      const uint4 ur = *(const uint4*)(U8 + (size_t)e * 1024);
      const uint4 vr = *(const uint4*)(V8 + (size_t)e * 1024);
      float d;
      dot_row(ur, x2, d);
      d = wave_sum(d);
      const float pre = d * r2 * usc[e];
      const float cf = gate[k] * vsc[e] * 0.5f * pre * (1.f + erff(pre * 0.7071067811865476f));
      axpy_row(vr, cf, acc);
    }
#pragma unroll
    for (int i = 0; i < 4; ++i)
      *(float4*)(orow + 4 * i) = make_float4(x2[2 * i][0] + acc[2 * i][0], x2[2 * i][1] + acc[2 * i][1], x2[2 * i + 1][0] + acc[2 * i + 1][0], x2[2 * i + 1][1] + acc[2 * i + 1][1]);
  }
}
#define XB_TMO      128
#define XB_XCNT(j)  (256  + 64 * (j))
#define XB_XSUB(j)  (1280 + 64 * (j))
#define XB_XGEN(j)  (2304 + 64 * (j))
#define XB_TOP      3328
#define XB_TOPGEN   3392
#define XCD_BAR_WORDS 3456
#define XB_SPIN_CAP (1u << 20)
#define LAS __attribute__((address_space(3)))
DI unsigned xb_ld(unsigned* p) { return __hip_atomic_load(p, __ATOMIC_RELAXED, __HIP_MEMORY_SCOPE_AGENT); }
DI unsigned xb_add(unsigned* p, unsigned v) { return __hip_atomic_fetch_add(p, v, __ATOMIC_RELAXED, __HIP_MEMORY_SCOPE_AGENT); }
DI unsigned xb_xcc_id() { return (unsigned)__builtin_amdgcn_s_getreg((3 << 11) | 20) & 0xFu; }
#define XB_SPIN(cond, bar) do { unsigned _sp = 0; while (cond) { __builtin_amdgcn_s_sleep(1); \
    if ((++_sp & 255u) == 0u) { if (xb_ld(&(bar)[XB_TMO])) break; if (_sp > XB_SPIN_CAP) { atomicAdd(&(bar)[XB_TMO], 1u); break; } } } } while (0)
struct XcdBarrier { unsigned* bar; unsigned x; volatile LAS unsigned* st; };
DI XcdBarrier xcd_barrier_post(unsigned* bar, volatile LAS unsigned* st) {
  XcdBarrier b; b.bar = bar; b.x = xb_xcc_id(); b.st = st;
  if (threadIdx.x == 0) (void)xb_add(&bar[XB_XCNT(b.x)], 1u);
  return b;
}
DI void xcd_barrier_complete(unsigned* bar, unsigned x, unsigned& nloc, unsigned& nx) {
  const unsigned G = gridDim.x * gridDim.y * gridDim.z;
  unsigned sum, cnt, mine, sp = 0u;
  for (;;) {
    sum = 0u; cnt = 0u; mine = 0u;
#pragma unroll
    for (unsigned j = 0; j < 16; ++j) { const unsigned c = xb_ld(&bar[XB_XCNT(j)]); sum += c; cnt += (c > 0u) ? 1u : 0u; mine = (j == x) ? c : mine; }
    if (sum == G) break;
    __builtin_amdgcn_s_sleep(1);
    if ((++sp & 255u) == 0u) { if (xb_ld(&bar[XB_TMO])) break; if (sp > XB_SPIN_CAP) { atomicAdd(&bar[XB_TMO], 1u); break; } }
  }
  nloc = mine > 0u ? mine : 1u; nx = cnt > 0u ? cnt : 1u;
}
DI void xcd_barrier(const XcdBarrier& b) {
  asm volatile("s_waitcnt vmcnt(0)" ::: "memory");
  __syncthreads();
  if (threadIdx.x == 0) {
    unsigned* bar = b.bar;
    __builtin_amdgcn_s_waitcnt(0);
    unsigned nloc = b.st[0], nx = b.st[1];
    if (nloc == 0u) { xcd_barrier_complete(bar, b.x, nloc, nx); b.st[0] = nloc; b.st[1] = nx; }
    const unsigned old = xb_add(&bar[XB_XSUB(b.x)], 1u);
    const unsigned gen = old / nloc;
    if (old + 1u == (gen + 1u) * nloc) {
      __builtin_amdgcn_fence(__ATOMIC_RELEASE, "agent");
      asm volatile("s_waitcnt vmcnt(0)" ::: "memory");
      const unsigned og = xb_add(&bar[XB_TOP], 1u);
      const unsigned tg = og / nx;
      if (og + 1u == (tg + 1u) * nx) xb_add(&bar[XB_TOPGEN], 1u);
      else XB_SPIN(xb_ld(&bar[XB_TOPGEN]) == tg, bar);
      __builtin_amdgcn_fence(__ATOMIC_ACQUIRE, "agent");
      xb_add(&bar[XB_XGEN(b.x)], 1u);
      asm volatile("s_waitcnt vmcnt(0)" ::: "memory");
    } else {
      XB_SPIN(xb_ld(&bar[XB_XGEN(b.x)]) == gen, bar);
      __builtin_amdgcn_fence(__ATOMIC_ACQUIRE, "agent");
      asm volatile("s_waitcnt vmcnt(0)" ::: "memory");
    }
  }
  __syncthreads();
}

#define LDS_TOTAL 147456
#define LDS_ALLOC (LDS_TOTAL + 16)
#define WS_BAR WS_END
#define N_PHASES 7
__global__ void __launch_bounds__(NTHREADS) mega_fwd(Params p) {
  extern __shared__ __attribute__((aligned(16))) char smem[];
  cg::grid_group grid = cg::this_grid();
  volatile LAS unsigned* xst = (volatile LAS unsigned*)(smem + LDS_TOTAL);
  if (threadIdx.x == 0) { xst[0] = 0u; xst[1] = 0u; xst[2] = 0u; xst[3] = 0u; }
  __syncthreads();
  const XcdBarrier xb = xcd_barrier_post((unsigned*)(p.ws + WS_BAR), xst);
#ifndef DOUBLE_MASK
#define DOUBLE_MASK 0
#endif
#define GRID_SYNC(k) do { if ((k) == 0) grid.sync(); else xcd_barrier(xb); } while (0)
#define RUN_PHASE(k, call) if (p.ph_lo <= (k) && (k) < p.ph_hi) { call; if ((DOUBLE_MASK >> (k)) & 1) { GRID_SYNC(k); call; } if ((k) + 1 < p.ph_hi) GRID_SYNC(k); }
  RUN_PHASE(0, phase_prep(p, smem))
  RUN_PHASE(1, phase_inproj(p, smem))
  RUN_PHASE(2, phase_mlaproj(p, smem))
  RUN_PHASE(3, phase_attn(p, smem))
  RUN_PHASE(4, phase_outproj(p, smem))
  RUN_PHASE(5, phase_peerq(p, smem))
#ifdef EXPERTS_SIMPLE
  RUN_PHASE(6, phase_experts_simple(p, smem))
#else
  RUN_PHASE(6, phase_experts(p, smem))
#endif
}

#ifndef N_LAUNCH_SPLIT
#define N_LAUNCH_SPLIT 0
#endif
extern "C" void kernel_launch(void* const* d_in, const int* in_sizes, int n_in, void* d_out, int out_size, void* d_ws,
                              size_t ws_size, hipStream_t stream) {
  static int grid = 0;
  if (grid == 0) {
    if (n_in != 18 || out_size != NTOK * 1024 || ws_size < WS_END + 65536) {
      fprintf(stderr, "kernel_launch: unexpected shapes (n_in %d out %d ws %zu need %llu)\n", n_in, out_size, ws_size, (unsigned long long)WS_END);
      grid = -1; return;
    }
    int dev = 0, cus = 0, per_cu = 0;
    hipGetDevice(&dev);
    hipDeviceGetAttribute(&cus, hipDeviceAttributeMultiprocessorCount, dev);
    hipFuncSetAttribute((const void*)mega_fwd, hipFuncAttributeMaxDynamicSharedMemorySize, LDS_ALLOC);
    hipOccupancyMaxActiveBlocksPerMultiprocessor(&per_cu, (const void*)mega_fwd, NTHREADS, LDS_ALLOC);
    if (per_cu < 1) { fprintf(stderr, "kernel_launch: occupancy query says %d blocks/CU\n", per_cu); grid = -1; return; }
    grid = cus;
    grid -= grid % 8;
    fprintf(stderr, "kernel_launch: grid %d (cus %d, per_cu %d)\n", grid, cus, per_cu);
  }
  if (grid < 0) return;
  Params p{};
  p.x = (const float*)d_in[0]; p.pos = (const int*)d_in[1]; p.attn_norm = (const float*)d_in[2]; p.w_in = (const float*)d_in[3];
  p.cq_norm = (const float*)d_in[4]; p.w_uq = (const float*)d_in[5]; p.ckv_norm = (const float*)d_in[6]; p.w_ukv = (const float*)d_in[7];
  p.q_norm = (const float*)d_in[8]; p.k_norm = (const float*)d_in[9]; p.sb_out_norm = (const float*)d_in[10];
  p.mla_out_norm = (const float*)d_in[11]; p.w_o = (const float*)d_in[12]; p.ffn_norm = (const float*)d_in[13];
  p.peer_wq = (const float*)d_in[14]; p.peer_sk = (const float*)d_in[15]; p.peer_u = (const float*)d_in[16]; p.peer_v = (const float*)d_in[17];
  p.out = (float*)d_out; p.ws = (char*)d_ws;
  (void)hipMemsetAsync((char*)d_ws + WS_BAR, 0, XCD_BAR_WORDS * 4, stream);
#if N_LAUNCH_SPLIT
  for (int ph = 0; ph < N_PHASES; ++ph) {
    p.ph_lo = ph; p.ph_hi = ph + 1;
    hipLaunchKernelGGL(mega_fwd, dim3(grid), dim3(NTHREADS), LDS_ALLOC, stream, p);
  }
#else
  p.ph_lo = 0; p.ph_hi = N_PHASES;
  void* args[] = {&p};
  hipError_t e = hipLaunchCooperativeKernel((const void*)mega_fwd, dim3(grid), dim3(NTHREADS), args, LDS_ALLOC, stream);
  if (e != hipSuccess) fprintf(stderr, "cooperative launch failed: %s (grid %d)\n", hipGetErrorString(e), grid);
#endif
}
```

```cpp
#include <hip/hip_runtime.h>
#include <hip/hip_cooperative_groups.h>
#include <cstdio>
namespace cg = cooperative_groups;

typedef unsigned short u16;
typedef unsigned int u32;
typedef short bf16x8 __attribute__((ext_vector_type(8)));
typedef float f32x16 __attribute__((ext_vector_type(16)));
typedef float f32x2 __attribute__((ext_vector_type(2)));
typedef __bf16 bf16x2_t __attribute__((ext_vector_type(2)));
#define DI __device__ __forceinline__

#define NTOK 65536
#define SEQ 4096
#define NB 16
#define DM 1024
#define INW 2208
#define INW_PAD 2304
#define NTHREADS 512

#define MB_ (1024ull * 1024ull)
#define WS_XB    (0ull)
#define WS_WINT  (128 * MB_)
#define WS_WUQT  (WS_WINT + 4718592ull)
#define WS_WUKVT (WS_WUQT + 589824ull)
#define WS_WOT   (WS_WUKVT + 524288ull)
#define WS_WPQT  (WS_WOT + 2097152ull)
#define WS_SUBK  (WS_WPQT + 4194304ull)
#define WS_UB    (WS_SUBK + 524288ull)
#define WS_VB    (WS_UB + 16 * MB_)
#define WS_RX    (WS_VB + 16 * MB_ + 131072ull)
#define WS_USC   (WS_VB + 16 * MB_)
#define WS_VSC   (WS_USC + 65536ull)
#define WS_R2    (WS_VB + 48 * MB_ + 1 * MB_)
#define WS_SBQ   (WS_R2)
#define WS_SBK   (WS_R2 + 64 * MB_)
#define WS_SBVT  (WS_R2 + 128 * MB_)
#define WS_IDX   (WS_R2)
#define WS_GATE  (WS_R2 + 32 * MB_)
#define WS_R3    (WS_R2 + 192 * MB_)
#define WS_CQ    (WS_R3)
#define WS_CKV   (WS_R3 + 48 * MB_)
#define WS_KPE   (WS_R3 + 80 * MB_)
#define WS_R4    (WS_R3 + 128 * MB_)
#define WS_MQ    (WS_R4)
#define WS_MK    (WS_R4 + 96 * MB_)
#define WS_MVT   (WS_R4 + 192 * MB_)
#define WS_SBO   (WS_R4 + 256 * MB_)
#define WS_MLAO  (WS_SBO + 64 * MB_)
#define WS_END   (WS_MLAO + 64 * MB_)

struct Params {
  const float* x; const int* pos; const float* attn_norm; const float* w_in; const float* cq_norm; const float* w_uq;
  const float* ckv_norm; const float* w_ukv; const float* q_norm; const float* k_norm; const float* sb_out_norm;
  const float* mla_out_norm; const float* w_o; const float* ffn_norm; const float* peer_wq; const float* peer_sk;
  const float* peer_u; const float* peer_v;
  float* out; char* ws;
  int ph_lo, ph_hi;
};

DI u32 pk_bf16(float a, float b) {
  f32x2 v = {a, b};
  bf16x2_t r = __builtin_convertvector(v, bf16x2_t);
  return __builtin_bit_cast(u32, r);
}
DI u16 f2bf(float a) { return (u16)(pk_bf16(a, 0.f) & 0xffffu); }
DI float bf_lo(u32 w) { return __uint_as_float(w << 16); }
DI float bf_hi(u32 w) { return __uint_as_float(w & 0xffff0000u); }
DI int crow(int reg, int h) { return (reg & 3) + 8 * (reg >> 2) + 4 * h; }
DI int swap23(int a) { return (a & ~12) | ((a >> 1) & 4) | ((a << 1) & 8); }
#define MFMA32(a, b, c) __builtin_amdgcn_mfma_f32_32x32x16_bf16((a), (b), (c), 0, 0, 0)
DI float shfl_xor_f(float v, int m) { return __shfl_xor(v, m, 64); }
DI int opaque_tid() { int t = threadIdx.x; asm volatile("" : "+v"(t)); return t; }
#ifndef XCD_CONSECUTIVE
#define XCD_CONSECUTIVE 0
#endif
#if XCD_CONSECUTIVE
#define VXCD ((int)(blockIdx.x / (gridDim.x >> 3)))
#define VCU  ((int)(blockIdx.x % (gridDim.x >> 3)))
#else
#define VXCD ((int)(blockIdx.x & 7))
#define VCU  ((int)(blockIdx.x >> 3))
#endif

template <typename ACC>
DI void store_block_bf16(u16* dst, const ACC& a, float sc, int lh) {
  u32 w[8];
#pragma unroll
  for (int g = 0; g < 4; ++g) { w[2 * g] = pk_bf16(a[4 * g] * sc, a[4 * g + 1] * sc); w[2 * g + 1] = pk_bf16(a[4 * g + 2] * sc, a[4 * g + 3] * sc); }
#pragma unroll
  for (int p2 = 0; p2 < 2; ++p2) {
    const auto r0 = __builtin_amdgcn_permlane32_swap(w[4 * p2], w[4 * p2 + 2], false, false);
    const auto r1 = __builtin_amdgcn_permlane32_swap(w[4 * p2 + 1], w[4 * p2 + 3], false, false);
    *(uint4*)(dst + 16 * p2 + 8 * lh) = make_uint4(r0[0], r1[0], r0[1], r1[1]);
  }
}
#ifndef GEMM_YOUNG_PRIO
#define GEMM_YOUNG_PRIO 1
#endif
typedef __attribute__((address_space(3))) unsigned lds_u32;
template <int N> DI void wait_vm() { asm volatile("s_waitcnt vmcnt(%0)" ::"n"(N) : "memory"); }
DI void block_barrier() { asm volatile("" ::: "memory"); __builtin_amdgcn_s_barrier(); asm volatile("" ::: "memory"); }
DI float dot2_self(u32 w, float c) {
  const bf16x2_t a = __builtin_bit_cast(bf16x2_t, w);
  return __builtin_amdgcn_fdot2_f32_bf16(a, a, c, false);
}

struct Seg { const u16* P; const u16* Q; int nk; };

template <int WP, int WQ, int PB, int QB, int NST, int SSQ>
struct GemmStream {
  static constexpr int TP = WP * PB * 32, TQ = WQ * QB * 32;
  static constexpr int NPP = TP / 64, NQP = TQ / 64, NPIECE = NPP + NQP;
  static constexpr int STAGE_BYTES = (TP + TQ) * 128;
  static constexpr int LDS_BYTES = NST * STAGE_BYTES;
  static constexpr int DEPTH = NST - 1;
  static constexpr int NSS = (SSQ == 1) ? QB : ((SSQ == 2) ? PB : 1);

  char* smem;
  int ldp, ldq;
  int st_issue, st_comp;
  int wave, wp, wq, l31, lh;
  unsigned p_off, q_off;
  unsigned lds_piece;
#ifdef GS_STAMP
  unsigned long long tacc[5];
  DI unsigned long long stamp() { unsigned long long t; asm volatile("s_memtime %0\n\ts_waitcnt lgkmcnt(0)" : "=s"(t) :: "memory"); return t; }
#endif

  DI void init(char* smem_, int ldp_, int ldq_) {
    smem = smem_; ldp = ldp_; ldq = ldq_;
    const int tid = opaque_tid(), lane = tid & 63;
    wave = __builtin_amdgcn_readfirstlane(tid >> 6); wp = wave / WQ; wq = wave % WQ; l31 = lane & 31; lh = lane >> 5;
    const int srow = 8 * wave + (lane >> 3);
    const int c = (lane & 7) ^ ((srow >> 1) & 7);
    p_off = (unsigned)(srow * ldp * 2 + c * 16);
    q_off = (unsigned)(srow * ldq * 2 + c * 16);
    lds_piece = (unsigned)(8 * wave * 128);
    st_issue = 0; st_comp = 0;
#ifdef GS_STAMP
    for (int i = 0; i < 5; ++i) tacc[i] = 0;
#endif
#if GEMM_YOUNG_PRIO
    if (wave >= 4) __builtin_amdgcn_s_setprio(1);
#endif
  }
  DI void issue_part(const Seg& s, int kt, int i0, int i1) {
    char* sb = smem + st_issue * STAGE_BYTES + lds_piece;
    const char* pg = (const char*)s.P + p_off + kt * 128;
    const char* qg = (const char*)s.Q + q_off + kt * 128;
#pragma unroll
    for (int i = 0; i < NPIECE; ++i) {
      if (i < i0 || i >= i1) continue;
      if (i < NPP) __builtin_amdgcn_global_load_lds((const unsigned*)(pg + (size_t)i * 64 * ldp * 2), (lds_u32*)(sb + i * 64 * 128), 16, 0, 0);
      else __builtin_amdgcn_global_load_lds((const unsigned*)(qg + (size_t)(i - NPP) * 64 * ldq * 2), (lds_u32*)(sb + TP * 128 + (i - NPP) * 64 * 128), 16, 0, 0);
    }
  }
  DI void issue_done() { st_issue = (st_issue + 1 == NST) ? 0 : st_issue + 1; }
  DI void issue(const Seg& s, int kt) { issue_part(s, kt, 0, NPIECE); issue_done(); }
  DI void load_frags(const char* sb, int ks, bf16x8 (&pf)[PB], bf16x8 (&qf)[QB]) {
#pragma unroll
    for (int pb = 0; pb < PB; ++pb) {
      const int r = wp * PB * 32 + pb * 32 + l31;
      pf[pb] = *(const bf16x8*)(sb + r * 128 + (((ks * 2 + lh) ^ ((r >> 1) & 7)) << 4));
    }
#pragma unroll
    for (int qb = 0; qb < QB; ++qb) {
      const int r = wq * QB * 32 + qb * 32 + l31;
      qf[qb] = *(const bf16x8*)(sb + TP * 128 + r * 128 + (((ks * 2 + lh) ^ ((r >> 1) & 7)) << 4));
    }
  }
  DI void compute(f32x16 (&acc)[PB][QB], float (&ss)[NSS], const Seg& is, int ikt) {
    const char* sb = smem + st_comp * STAGE_BYTES;
    if (DEPTH < 2) issue_part(is, ikt, 0, NPIECE);
#pragma unroll
    for (int ks = 0; ks < 4; ++ks) {
      bf16x8 pf[PB], qf[QB];
      load_frags(sb, ks, pf, qf);
#pragma unroll
      for (int pb = 0; pb < PB; ++pb)
#pragma unroll
        for (int qb = 0; qb < QB; ++qb) acc[pb][qb] = MFMA32(pf[pb], qf[qb], acc[pb][qb]);
      if (DEPTH >= 2) issue_part(is, ikt, (ks * NPIECE) / 4, ((ks + 1) * NPIECE) / 4);
      if (SSQ == 1) {
#pragma unroll
        for (int qb = 0; qb < QB; ++qb) {
          const uint4 w = __builtin_bit_cast(uint4, qf[qb]);
          ss[qb] = dot2_self(w.x, ss[qb]); ss[qb] = dot2_self(w.y, ss[qb]); ss[qb] = dot2_self(w.z, ss[qb]); ss[qb] = dot2_self(w.w, ss[qb]);
        }
      } else if (SSQ == 2) {
#pragma unroll
        for (int pb = 0; pb < PB; ++pb) {
          const uint4 w = __builtin_bit_cast(uint4, pf[pb]);
          ss[pb] = dot2_self(w.x, ss[pb]); ss[pb] = dot2_self(w.y, ss[pb]); ss[pb] = dot2_self(w.z, ss[pb]); ss[pb] = dot2_self(w.w, ss[pb]);
        }
      }
    }
    issue_done();
    st_comp = (st_comp + 1 == NST) ? 0 : st_comp + 1;
  }
  DI void prologue(const Seg& s) {
#pragma unroll
    for (int d = 0; d < DEPTH; ++d) issue(s, d);
  }
  DI void run(f32x16 (&acc)[PB][QB], float (&ss)[NSS], const Seg& cur, const Seg& nxt) {
#pragma unroll
    for (int i = 0; i < NSS; ++i) ss[i] = 0.f;
    const int nk = cur.nk;
#pragma unroll 1
    for (int kt = 0; kt < nk; ++kt) {
#ifdef GS_STAMP
      __builtin_amdgcn_sched_barrier(0); const unsigned long long t0 = stamp(); __builtin_amdgcn_sched_barrier(0);
#endif
      wait_vm<(DEPTH - 1) * NPIECE>();
#ifdef GS_STAMP
      __builtin_amdgcn_sched_barrier(0); const unsigned long long t1 = stamp(); __builtin_amdgcn_sched_barrier(0);
#endif
      block_barrier();
#ifdef GS_STAMP
      __builtin_amdgcn_sched_barrier(0); const unsigned long long t2 = stamp(); __builtin_amdgcn_sched_barrier(0);
#endif
      {
        const bool in_cur = kt + DEPTH < nk;
        Seg is; is.P = in_cur ? cur.P : nxt.P; is.Q = in_cur ? cur.Q : nxt.Q; is.nk = 0;
        compute(acc, ss, is, in_cur ? kt + DEPTH : kt + DEPTH - nk);
      }
#ifdef GS_STAMP
      __builtin_amdgcn_sched_barrier(0); const unsigned long long t4 = stamp(); __builtin_amdgcn_sched_barrier(0);
      tacc[0] += t1 - t0; tacc[1] += t2 - t1; tacc[3] += t4 - t2; tacc[4] += 1;
#endif
    }
#pragma unroll
    for (int i = 0; i < NSS; ++i) ss[i] += shfl_xor_f(ss[i], 32);
  }
  DI void drain() {
    wait_vm<0>();
    block_barrier();
    st_issue = 0; st_comp = 0;
#if GEMM_YOUNG_PRIO
    __builtin_amdgcn_s_setprio(0);
#endif
  }
};

template <int PB, int QB>
DI void zero_acc(f32x16 (&acc)[PB][QB]) {
#pragma unroll
  for (int a = 0; a < PB; ++a)
#pragma unroll
    for (int b = 0; b < QB; ++b)
#pragma unroll
      for (int r = 0; r < 16; ++r) acc[a][b][r] = 0.f;
}
DI void prep_transpose_tile(u16* __restrict__ dst, const float* __restrict__ src, const float* __restrict__ gain,
                            int N, int K, int tn, int tk, int n_scaled, float nscale, char* smem) {
  float* tile = (float*)smem;
  const int tid = opaque_tid();
  const int c = tid & 63, r0 = tid >> 6;
#pragma unroll
  for (int i = 0; i < 8; ++i) {
    const int kr = r0 + i * 8, k = tk * 64 + kr, n = tn * 64 + c;
    float v = 0.f;
    if (n < N) v = src[(size_t)k * N + n] * (gain ? gain[k] : 1.f);
    tile[kr * 65 + c] = v;
  }
  __syncthreads();
#pragma unroll
  for (int i = 0; i < 8; ++i) {
    const int nr = r0 + i * 8, n = tn * 64 + nr, k = tk * 64 + c;
    float v = tile[c * 65 + nr];
    if (n < n_scaled) v *= nscale;
    dst[(size_t)n * K + k] = f2bf(v);
  }
  __syncthreads();
}

DI u32 pack_i8(float a, float b, float c, float d) {
  const int ia = __float2int_rn(a), ib = __float2int_rn(b), ic = __float2int_rn(c), id = __float2int_rn(d);
  return ((u32)ia & 255u) | (((u32)ib & 255u) << 8) | (((u32)ic & 255u) << 16) | ((u32)id << 24);
}
DI u32 fp6_code(float q) {
  const u32 b = __float_as_uint(q);
  const u32 sg = (b >> 26) & 32u;
  const u32 ab = b & 0x7fffffffu;
  const float a = __uint_as_float(ab);
  const u32 rn = (ab + 0x7ffffu + ((ab >> 20) & 1u)) >> 20;
  u32 c = (a < 1.f) ? (u32)__float2int_rn(a * 8.f) : (rn - 1008u);
  c = c < 31u ? c : 31u;
  return sg | c;
}
DI void phase_prep(const Params& p, char* smem) {
  const int tid = opaque_tid();
  const size_t gtid = (size_t)blockIdx.x * NTHREADS + tid, gstride = (size_t)gridDim.x * NTHREADS;
  char* ws = p.ws;
  {
    const int n0 = 36 * 16, n1 = n0 + 12 * 6, n2 = n1 + 16 * 4, n3 = n2 + 16 * 16, n4 = n3 + 32 * 16;
    for (int w = blockIdx.x; w < n4; w += gridDim.x) {
      if (w < n0) {
        prep_transpose_tile((u16*)(ws + WS_WINT), p.w_in, p.attn_norm, INW, 1024, w / 16, w % 16, 512, 0.125f * 1.4426950408889634f, smem);
      } else if (w < n1) {
        const int v = w - n0; prep_transpose_tile((u16*)(ws + WS_WUQT), p.w_uq, p.cq_norm, 768, 384, v / 6, v % 6, 0, 1.f, smem);
      } else if (w < n2) {
        const int v = w - n1; prep_transpose_tile((u16*)(ws + WS_WUKVT), p.w_ukv, p.ckv_norm, 1024, 256, v / 4, v % 4, 0, 1.f, smem);
      } else if (w < n3) {
        const int v = w - n2; const int tk = v % 16;
        prep_transpose_tile((u16*)(ws + WS_WOT), p.w_o, (tk < 8) ? p.sb_out_norm : (p.mla_out_norm - 512), 1024, 1024, v / 16, tk, 0, 1.f, smem);
      } else {
        const int v = w - n3; prep_transpose_tile((u16*)(ws + WS_WPQT), p.peer_wq, p.ffn_norm, 2048, 1024, v / 16, v % 16, 0, 1.f, smem);
      }
    }
  }
  if (blockIdx.x == 0 && tid < 8) ((unsigned*)(ws + WS_END + 49152))[64 * tid] = 0u;
  {
    u16* dst = (u16*)(ws + WS_SUBK);
    for (size_t i = gtid; i < 2ull * 8 * 128 * 128; i += gstride) {
      const int pp = (int)(i & 127);
      const int d = (pp & ~15) | swap23(pp & 15);
      dst[i] = f2bf(p.peer_sk[(i & ~127ull) | d]);
    }
  }
  {
    const int lane = tid & 63;
    const int gw = blockIdx.x * 8 + (tid >> 6), nw = gridDim.x * 8;
    float* rx = (float*)(ws + WS_RX);
    for (int row0 = gw * 4; row0 < NTOK; row0 += nw * 4) {
      float4 a[4][4];
#pragma unroll
      for (int r = 0; r < 4; ++r)
#pragma unroll
        for (int i = 0; i < 4; ++i) a[r][i] = ((const float4*)(p.x + (size_t)(row0 + r) * 1024))[lane + 64 * i];
#pragma unroll
      for (int r = 0; r < 4; ++r) {
        uint2* dst = (uint2*)(ws + WS_XB + (size_t)(row0 + r) * 2048);
        float ss = 0.f;
#pragma unroll
        for (int i = 0; i < 4; ++i) {
          const float4 v = a[r][i];
          ss += v.x * v.x + v.y * v.y + v.z * v.z + v.w * v.w;
          dst[lane + 64 * i] = make_uint2(pk_bf16(v.x, v.y), pk_bf16(v.z, v.w));
        }
        ss += shfl_xor_f(ss, 32); ss += shfl_xor_f(ss, 16); ss += shfl_xor_f(ss, 8); ss += shfl_xor_f(ss, 4); ss += shfl_xor_f(ss, 2); ss += shfl_xor_f(ss, 1);
        if (lane == 0) rx[row0 + r] = rsqrtf(ss * (1.f / 1024.f) + 1e-6f);
      }
    }
  }
  {
    const int lane = tid & 63;
    const int gw = blockIdx.x * 8 + (tid >> 6), nw = gridDim.x * 8;
    const float4* g4 = (const float4*)p.ffn_norm;
    for (int row0 = gw * 4; row0 < 2 * 16384; row0 += nw * 4) {
      const bool isv = row0 >= 16384;
      const int e0 = row0 & 16383;
      float4 v[4][4];
#pragma unroll
      for (int r = 0; r < 4; ++r)
#pragma unroll
        for (int i = 0; i < 4; ++i) v[r][i] = ((const float4*)((isv ? p.peer_v : p.peer_u) + (size_t)(e0 + r) * 1024))[lane + 64 * i];
      float4 g[4];
#pragma unroll
      for (int i = 0; i < 4; ++i) g[i] = isv ? make_float4(1.f, 1.f, 1.f, 1.f) : g4[lane + 64 * i];
#pragma unroll
      for (int r = 0; r < 4; ++r) {
        float m = 0.f;
#pragma unroll
        for (int i = 0; i < 4; ++i) {
          v[r][i].x *= g[i].x; v[r][i].y *= g[i].y; v[r][i].z *= g[i].z; v[r][i].w *= g[i].w;
          m = fmaxf(m, fmaxf(fmaxf(fabsf(v[r][i].x), fabsf(v[r][i].y)), fmaxf(fabsf(v[r][i].z), fabsf(v[r][i].w))));
        }
        m = fmaxf(m, shfl_xor_f(m, 32)); m = fmaxf(m, shfl_xor_f(m, 16)); m = fmaxf(m, shfl_xor_f(m, 8));
        m = fmaxf(m, shfl_xor_f(m, 4)); m = fmaxf(m, shfl_xor_f(m, 2)); m = fmaxf(m, shfl_xor_f(m, 1));
        if (isv) {
          const float sc = (m > 0.f) ? 7.5f / m : 1.f;
          u32 c[16];
#pragma unroll
          for (int i = 0; i < 4; ++i) {
            c[4 * i] = fp6_code(v[r][i].x * sc); c[4 * i + 1] = fp6_code(v[r][i].y * sc);
            c[4 * i + 2] = fp6_code(v[r][i].z * sc); c[4 * i + 3] = fp6_code(v[r][i].w * sc);
          }
          const u32 w0 = c[0] | (c[1] << 6) | (c[2] << 12) | (c[3] << 18) | (c[4] << 24) | (c[5] << 30);
          const u32 w1 = (c[5] >> 2) | (c[6] << 4) | (c[7] << 10) | (c[8] << 16) | (c[9] << 22) | (c[10] << 28);
          const u32 w2 = (c[10] >> 4) | (c[11] << 2) | (c[12] << 8) | (c[13] << 14) | (c[14] << 20) | (c[15] << 26);
          u32* dst = (u32*)(ws + WS_VB + (size_t)(e0 + r) * 768) + 3 * lane;
          *(uint3*)dst = make_uint3(w0, w1, w2);
          if (lane == 0) ((float*)(ws + WS_VSC))[e0 + r] = (m > 0.f) ? m * (1.f / 7.5f) : 1.f;
        } else {
          const float sc = (m > 0.f) ? 127.f / m : 1.f;
          u32 wq[4];
#pragma unroll
          for (int i = 0; i < 4; ++i) wq[i] = pack_i8(v[r][i].x * sc, v[r][i].y * sc, v[r][i].z * sc, v[r][i].w * sc);
          *(uint4*)(ws + WS_UB + (size_t)(e0 + r) * 1024 + 16 * lane) = make_uint4(wq[0], wq[1], wq[2], wq[3]);
          if (lane == 0) ((float*)(ws + WS_USC))[e0 + r] = (m > 0.f) ? m * (1.f / 127.f) : 1.f;
        }
      }
    }
  }
}

typedef GemmStream<2, 4, 2, 2, 3, 0> G1;
DI void phase_inproj(const Params& p, char* smem) {
  char* ws = p.ws;
  const int tid = opaque_tid(), lane = tid & 63, wave = tid >> 6;
  const int wp = wave / 4, wq = wave % 4, l31 = lane & 31, lh = lane >> 5;
  const int xcd = VXCD, cu = VCU, ncu = gridDim.x >> 3;
  G1 gs; gs.init(smem, 1024, 1024);
#ifdef GS_STAMP
  const unsigned long long ph_c0 = __builtin_amdgcn_s_memtime(), ph_r0 = __builtin_amdgcn_s_memrealtime();
#endif
  auto tile_nt = [&](int w) { return (w % 144) / 8; };
  auto tile_tt = [&](int w) { return ((w / 144) * 8 + (w % 8)) * 8 + xcd; };
  auto seg = [&](int w) { Seg s; s.P = (const u16*)(ws + WS_WINT) + (size_t)tile_nt(w) * 128 * 1024; s.Q = (const u16*)(ws + WS_XB) + (size_t)tile_tt(w) * 256 * 1024; s.nk = 16; return s; };
  Seg cur = seg(cu);
  gs.prologue(cur);
  for (int w = cu; w < 32 * 18; w += ncu) {
    const int tt = tile_tt(w), nt = tile_nt(w);
    const Seg nxt = (w + ncu < 32 * 18) ? seg(w + ncu) : cur;
    f32x16 acc[2][2];
    float ssq[1];
    zero_acc(acc);
    gs.run(acc, ssq, cur, nxt);
    cur = nxt;
#pragma unroll
    for (int qb = 0; qb < 2; ++qb) {
      const int tl = wq * 64 + qb * 32 + l31;
      const int t = tt * 256 + tl;
      const float rt = ((const float*)(ws + WS_RX))[t];
#pragma unroll
      for (int pb = 0; pb < 2; ++pb) {
        const int nb = nt * 128 + wp * 64 + pb * 32;
        if (nb >= INW) continue;
        if (nb < 1024) {
          u16* dst = (u16*)(ws + (nb < 512 ? WS_SBQ : WS_SBK)) + (size_t)t * 512 + (nb & 511);
          store_block_bf16(dst, acc[pb][qb], rt, lh);
        } else if (nb < 1536) {
          const int hd = (nb - 1024);
          const int b = t >> 12, s = t & 4095;
          const int sp = (s & ~15) | swap23(s & 15);
          u16* dst = (u16*)(ws + WS_SBVT) + ((size_t)b * 512 + hd) * 4096 + sp;
#pragma unroll
          for (int r = 0; r < 16; ++r) dst[(size_t)crow(r, lh) * 4096] = f2bf(acc[pb][qb][r] * rt);
        } else if (nb < 1920) {
          u16* dst = (u16*)(ws + WS_CQ) + (size_t)t * 384 + (nb - 1536);
          store_block_bf16(dst, acc[pb][qb], rt, lh);
        } else if (nb < 2176) {
          u16* dst = (u16*)(ws + WS_CKV) + (size_t)t * 256 + (nb - 1920);
          store_block_bf16(dst, acc[pb][qb], rt, lh);
        } else {
          float* dst = (float*)(ws + WS_KPE) + (size_t)t * 32;
#pragma unroll
          for (int g = 0; g < 4; ++g) {
            const f32x16& a = acc[pb][qb];
            *(float4*)(dst + 8 * g + 4 * lh) = make_float4(a[4 * g] * rt, a[4 * g + 1] * rt, a[4 * g + 2] * rt, a[4 * g + 3] * rt);
          }
        }
      }
    }
  }
  gs.drain();
#ifdef GS_STAMP
  if (blockIdx.x == GS_STAMP_BLK && (threadIdx.x >> 6) == GS_STAMP_WAVE && (threadIdx.x & 63) == 0) {
    unsigned long long* d = (unsigned long long*)(ws + WS_END + 32768);
    for (int i = 0; i < 5; ++i) d[i] = gs.tacc[i];
    d[5] = __builtin_amdgcn_s_memtime() - ph_c0; d[6] = (__builtin_amdgcn_s_memrealtime() - ph_r0) * 10;
  }
#endif
}
DI float rope_invf(int i0, int lh) {
  constexpr float C[16] = {1.0f, 0.5623413251903491f, 0.31622776601683794f, 0.17782794100389228f, 0.1f, 0.05623413251903491f,
                           0.03162277660168379f, 0.01778279410038923f, 0.01f, 0.005623413251903491f, 0.0031622776601683794f,
                           0.0017782794100389228f, 0.001f, 0.0005623413251903491f, 0.00031622776601683794f, 0.00017782794100389228f};
  return lh ? C[i0 + 4] : C[i0];
}
DI void sincos_turns(float ang, float& s, float& c) {
  float tr = ang * 0.15915494309189535f;
  tr = tr - floorf(tr);
  s = __builtin_amdgcn_sinf(tr);
  c = __builtin_amdgcn_cosf(tr);
}

typedef GemmStream<2, 4, 3, 1, 3, 1> G2Q;
typedef GemmStream<2, 4, 4, 1, 3, 1> G2KV;

DI void mla_q_tile(const Params& p, G2Q& gs, const Seg& cur, const Seg& nxt, int tt, int nt) {
  char* ws = p.ws;
  const int tid = opaque_tid(), lane = tid & 63, wave = tid >> 6;
  const int wp = wave / 4, wq = wave % 4, l31 = lane & 31, lh = lane >> 5;
  float ssq[1];
  f32x16 acc[3][1];
  zero_acc(acc);
  gs.run(acc, ssq, cur, nxt);
  const int hd = nt * 2 + wp;
  const float qscale = 0.10206207261596577f * 1.4426950408889634f;
#pragma unroll
  for (int qb = 0; qb < 1; ++qb) {
    const int tl = wq * 32 + l31;
    const int t = tt * 128 + tl;
    const float rc = rsqrtf(ssq[0] * (1.f / 384.f) + 1e-6f);
    float ss = 0.f;
#pragma unroll
    for (int pb = 0; pb < 3; ++pb)
#pragma unroll
      for (int r = 0; r < 16; ++r) { const float v = acc[pb][qb][r] * rc; acc[pb][qb][r] = v; ss += v * v; }
    ss += shfl_xor_f(ss, 32);
    const float rq = rsqrtf(ss * (1.f / 96.f) + 1e-6f) ;
#pragma unroll
    for (int pb = 0; pb < 3; ++pb)
#pragma unroll
      for (int g = 0; g < 4; ++g) {
        const float4 gn = *(const float4*)(p.q_norm + pb * 32 + 8 * g + 4 * lh);
        acc[pb][qb][4 * g] *= rq * gn.x; acc[pb][qb][4 * g + 1] *= rq * gn.y; acc[pb][qb][4 * g + 2] *= rq * gn.z; acc[pb][qb][4 * g + 3] *= rq * gn.w;
      }
    const float posf = (float)p.pos[t];
#pragma unroll
    for (int r = 0; r < 8; ++r) {
      const int i0 = (r & 3) + 8 * (r >> 2);
      float s, c; sincos_turns(posf * rope_invf(i0, lh), s, c);
      const float x1 = acc[2][qb][r], x2 = acc[2][qb][r + 8];
      acc[2][qb][r] = x1 * c - x2 * s;
      acc[2][qb][r + 8] = x1 * s + x2 * c;
    }
    const int b = t >> 12, sidx = t & 4095;
    u16* dst = (u16*)(ws + WS_MQ) + ((size_t)(b * 8 + hd) * 4096 + sidx) * 96;
#pragma unroll
    for (int pb = 0; pb < 3; ++pb) store_block_bf16(dst + pb * 32, acc[pb][qb], qscale, lh);
  }
}

DI void mla_kv_tile(const Params& p, G2KV& gs, const Seg& cur, const Seg& nxt, int tt, int nt) {
  char* ws = p.ws;
  const int tid = opaque_tid(), lane = tid & 63, wave = tid >> 6;
  const int wp = wave / 4, wq = wave % 4, l31 = lane & 31, lh = lane >> 5;
  float ssq[1];
  f32x16 acc[4][1];
  zero_acc(acc);
  gs.run(acc, ssq, cur, nxt);
  const int hd = nt * 2 + wp;
#pragma unroll
  for (int qb = 0; qb < 1; ++qb) {
    const int tl = wq * 32 + l31;
    const int t = tt * 128 + tl;
    const float rkv = rsqrtf(ssq[0] * (1.f / 256.f) + 1e-6f);
    float kp[16];
    const float* kpe = (const float*)(ws + WS_KPE) + (size_t)t * 32;
#pragma unroll
    for (int g = 0; g < 4; ++g) {
      const float4 v = *(const float4*)(kpe + 8 * g + 4 * lh);
      kp[4 * g] = v.x; kp[4 * g + 1] = v.y; kp[4 * g + 2] = v.z; kp[4 * g + 3] = v.w;
    }
    float ss = 0.f;
#pragma unroll
    for (int pb = 0; pb < 2; ++pb)
#pragma unroll
      for (int r = 0; r < 16; ++r) { const float v = acc[pb][qb][r] * rkv; acc[pb][qb][r] = v; ss += v * v; }
#pragma unroll
    for (int r = 0; r < 16; ++r) ss += kp[r] * kp[r];
    ss += shfl_xor_f(ss, 32);
    const float rk = rsqrtf(ss * (1.f / 96.f) + 1e-6f);
#pragma unroll
    for (int pb = 0; pb < 2; ++pb)
#pragma unroll
      for (int g = 0; g < 4; ++g) {
        const float4 gn = *(const float4*)(p.k_norm + pb * 32 + 8 * g + 4 * lh);
        acc[pb][qb][4 * g] *= rk * gn.x; acc[pb][qb][4 * g + 1] *= rk * gn.y; acc[pb][qb][4 * g + 2] *= rk * gn.z; acc[pb][qb][4 * g + 3] *= rk * gn.w;
      }
#pragma unroll
    for (int g = 0; g < 4; ++g) {
      const float4 gn = *(const float4*)(p.k_norm + 64 + 8 * g + 4 * lh);
      kp[4 * g] *= rk * gn.x; kp[4 * g + 1] *= rk * gn.y; kp[4 * g + 2] *= rk * gn.z; kp[4 * g + 3] *= rk * gn.w;
    }
    const float posf = (float)p.pos[t];
#pragma unroll
    for (int r = 0; r < 8; ++r) {
      const int i0 = (r & 3) + 8 * (r >> 2);
      float s, c; sincos_turns(posf * rope_invf(i0, lh), s, c);
      const float x1 = kp[r], x2 = kp[r + 8];
      kp[r] = x1 * c - x2 * s;
      kp[r + 8] = x1 * s + x2 * c;
    }
    const int b = t >> 12, sidx = t & 4095;
    u16* dst = (u16*)(ws + WS_MK) + ((size_t)(b * 8 + hd) * 4096 + sidx) * 96;
#pragma unroll
    for (int pb = 0; pb < 2; ++pb) store_block_bf16(dst + pb * 32, acc[pb][qb], 1.f, lh);
    store_block_bf16(dst + 64, kp, 1.f, lh);
    const int sp = (sidx & ~15) | swap23(sidx & 15);
    u16* dv = (u16*)(ws + WS_MVT) + ((size_t)(b * 8 + hd) * 64) * 4096 + sp;
#pragma unroll
    for (int pb = 2; pb < 4; ++pb)
#pragma unroll
      for (int r = 0; r < 16; ++r) dv[(size_t)((pb - 2) * 32 + crow(r, lh)) * 4096] = f2bf(acc[pb][qb][r] * rkv);
  }
}

DI void phase_mlaproj(const Params& p, char* smem) {
  char* ws = p.ws;
  const int xcd = VXCD, cu = VCU, ncu = gridDim.x >> 3;
  {
    G2Q gs; gs.init(smem, 384, 384);
    auto seg = [&](int w) { Seg s; s.P = (const u16*)(ws + WS_WUQT) + (size_t)(w % 4) * 192 * 384; s.Q = (const u16*)(ws + WS_CQ) + (size_t)((w / 4) * 8 + xcd) * 128 * 384; s.nk = 6; return s; };
    Seg cur = seg(cu);
    gs.prologue(cur);
    for (int w = cu; w < 64 * 4; w += ncu) {
      const Seg nxt = (w + ncu < 64 * 4) ? seg(w + ncu) : cur;
      mla_q_tile(p, gs, cur, nxt, (w / 4) * 8 + xcd, w % 4);
      cur = nxt;
    }
    gs.drain();
  }
  {
    G2KV gs; gs.init(smem, 256, 256);
    auto seg = [&](int w) { Seg s; s.P = (const u16*)(ws + WS_WUKVT) + (size_t)(w % 4) * 256 * 256; s.Q = (const u16*)(ws + WS_CKV) + (size_t)((w / 4) * 8 + xcd) * 128 * 256; s.nk = 4; return s; };
    Seg cur = seg(cu);
    gs.prologue(cur);
    for (int w = cu; w < 64 * 4; w += ncu) {
      const Seg nxt = (w + ncu < 64 * 4) ? seg(w + ncu) : cur;
      mla_kv_tile(p, gs, cur, nxt, (w / 4) * 8 + xcd, w % 4);
      cur = nxt;
    }
    gs.drain();
  }
}
#define MLA_KROW 208
#define MLA_KBUF (64 * MLA_KROW)
#define MLA_VBUF (64 * 128)
#define MLA_KB2 12288
#define MLA_QOFF (2 * MLA_KB2 + 2 * MLA_VBUF)
DI void mla_attn_block512(const Params& p, char* smem, int b, int hd, int qblk, float Mb) {
  char* ws = p.ws;
  const int tid = opaque_tid(), lane = tid & 63, wave = __builtin_amdgcn_readfirstlane(tid >> 6), l31 = lane & 31, lh = lane >> 5;
  const int q0 = qblk * 512;
  const int nkt = q0 / 64 + 8;
  const int my_nkt = q0 / 64 + wave + 1;
  const char* Kg = (const char*)((const u16*)(ws + WS_MK) + (size_t)(b * 8 + hd) * 4096 * 96);
  const char* Vg = (const char*)((const u16*)(ws + WS_MVT) + (size_t)(b * 8 + hd) * 64 * 4096);
  char* Qs = smem + MLA_QOFF + wave * 64 * MLA_KROW;
  {
    const u16* Qg = (const u16*)(ws + WS_MQ) + ((size_t)(b * 8 + hd) * 4096 + q0 + wave * 64 + lane) * 96;
#pragma unroll 4
    for (int c = 0; c < 12; ++c) *(uint4*)(Qs + lane * MLA_KROW + c * 16) = *(const uint4*)(Qg + 8 * c);
  }
  f32x16 o[2][2];
#pragma unroll
  for (int g = 0; g < 2; ++g)
#pragma unroll
    for (int d = 0; d < 2; ++d)
#pragma unroll
      for (int r = 0; r < 16; ++r) o[g][d][r] = 0.f;
  float lsum0 = 0.f, lsum1 = 0.f;

  char* Kb = smem;
  char* Vb = smem + 2 * MLA_KB2;
  unsigned ksrc0, ksrc1, vsrc;
  {
    const int o0 = wave * 1024 + lane * 16, r0 = o0 / 192, c0 = (o0 % 192) >> 4;
    ksrc0 = (unsigned)(r0 * 192 + ((c0 & ~3) | ((c0 & 3) ^ ((r0 >> 2) & 3))) * 16);
    const int o1 = (8 + (wave & 3)) * 1024 + lane * 16, r1 = o1 / 192, c1 = (o1 % 192) >> 4;
    ksrc1 = (unsigned)(r1 * 192 + ((c1 & ~3) | ((c1 & 3) ^ ((r1 >> 2) & 3))) * 16);
    const int vr = wave * 8 + (lane >> 3), vc = (lane & 7) ^ ((vr >> 1) & 7);
    vsrc = (unsigned)(vr * 8192 + vc * 16);
  }
  auto issue = [&](int kt, int buf) {
    const char* kg = Kg + (size_t)kt * 64 * 192;
    __builtin_amdgcn_global_load_lds((const unsigned*)(kg + ksrc0), (lds_u32*)(Kb + buf * MLA_KB2 + wave * 1024), 16, 0, 0);
    if (wave < 4) __builtin_amdgcn_global_load_lds((const unsigned*)(kg + ksrc1), (lds_u32*)(Kb + buf * MLA_KB2 + (8 + wave) * 1024), 16, 0, 0);
    __builtin_amdgcn_global_load_lds((const unsigned*)(Vg + (size_t)kt * 128 + vsrc), (lds_u32*)(Vb + buf * MLA_VBUF + wave * 1024), 16, 0, 0);
  };
  auto qk = [&](f32x16 (&st)[2], const char* Qr, const char* Ks, float mb) {
#pragma unroll
    for (int kb = 0; kb < 2; ++kb)
#pragma unroll
      for (int r = 0; r < 16; ++r) st[kb][r] = -mb;
#pragma unroll
    for (int s = 0; s < 6; ++s) {
      const bf16x8 q = *(const bf16x8*)(Qr + l31 * MLA_KROW + (2 * s + lh) * 16);
#pragma unroll
      for (int kb = 0; kb < 2; ++kb) {
        const int r = kb * 32 + l31, c = 2 * s + lh;
        const bf16x8 kf = *(const bf16x8*)(Ks + r * 192 + (((c & ~3) | ((c & 3) ^ ((r >> 2) & 3))) << 4));
        st[kb] = MFMA32(kf, q, st[kb]);
      }
    }
  };
  auto softmax = [&](const f32x16 (&st)[2], bf16x8 (&pf)[4], float& lsum) {
#pragma unroll
    for (int kb = 0; kb < 2; ++kb) {
      float e[16];
#pragma unroll
      for (int r = 0; r < 16; ++r) { e[r] = __builtin_amdgcn_exp2f(st[kb][r]); lsum += e[r]; }
#pragma unroll
      for (int s2 = 0; s2 < 2; ++s2) {
        uint4 w = make_uint4(pk_bf16(e[8 * s2], e[8 * s2 + 1]), pk_bf16(e[8 * s2 + 2], e[8 * s2 + 3]),
                             pk_bf16(e[8 * s2 + 4], e[8 * s2 + 5]), pk_bf16(e[8 * s2 + 6], e[8 * s2 + 7]));
        pf[kb * 2 + s2] = __builtin_bit_cast(bf16x8, w);
      }
    }
  };
  auto pv = [&](f32x16 (&oo)[2], const bf16x8 (&pf)[4], const char* Vs) {
#pragma unroll
    for (int ks = 0; ks < 4; ++ks)
#pragma unroll
      for (int db = 0; db < 2; ++db) {
        const int r = db * 32 + l31;
        const bf16x8 vf = *(const bf16x8*)(Vs + r * 128 + (((2 * ks + lh) ^ ((r >> 1) & 7)) << 4));
        oo[db] = MFMA32(vf, pf[ks], oo[db]);
      }
  };
  issue(0, 0);
  wait_vm<0>();
  block_barrier();
#pragma unroll 1
  for (int t = 0; t < nkt; ++t) {
    if (t + 1 < nkt) issue(t + 1, (t + 1) & 1);
    if (t < my_nkt) {
      const char* Ks = Kb + (t & 1) * MLA_KB2;
      const char* Vs = Vb + (t & 1) * MLA_VBUF;
      float mb = Mb;
      asm volatile("" : "+v"(mb));
      f32x16 sa[2], sb[2];
      bf16x8 pfa[4], pfb[4];
      qk(sa, Qs, Ks, mb);
      qk(sb, Qs + 32 * MLA_KROW, Ks, mb);
      softmax(sa, pfa, lsum0);
      pv(o[0], pfa, Vs);
      softmax(sb, pfb, lsum1);
      pv(o[1], pfb, Vs);
    }
    wait_vm<0>();
    block_barrier();
  }
#pragma unroll
  for (int g = 0; g < 2; ++g) {
    float lsum = g ? lsum1 : lsum0;
    lsum += shfl_xor_f(lsum, 32);
    const float inv = 1.f / lsum;
    const int tq = b * 4096 + q0 + wave * 64 + g * 32 + l31;
    u16* dst = (u16*)(ws + WS_MLAO) + (size_t)tq * 512 + hd * 64;
#pragma unroll
    for (int db = 0; db < 2; ++db)
#pragma unroll
      for (int gg = 0; gg < 4; ++gg) {
        const f32x16& a = o[g][db];
        *(uint2*)(dst + db * 32 + 8 * gg + 4 * lh) = make_uint2(pk_bf16(a[4 * gg] * inv, a[4 * gg + 1] * inv), pk_bf16(a[4 * gg + 2] * inv, a[4 * gg + 3] * inv));
      }
  }
}

#define SBW_BACK 192
#define SBW_KOFF 0
#define SBW_VOFF 57344
#define SBW_VPITCH 912
DI void sb_attn_block256(const Params& p, char* smem, int b, int hd, int R0) {
  char* ws = p.ws;
  asm volatile("" : "+s"(ws));
  const int tid = opaque_tid(), lane = tid & 63, wave = __builtin_amdgcn_readfirstlane(tid >> 6), l31 = lane & 31, lh = lane >> 5;
  const int wlo = (R0 >= SBW_BACK) ? R0 - SBW_BACK : 0;
  const int nkeys = R0 + 256 - wlo;
  {
    const char* Kgw = (const char*)((const u16*)(ws + WS_SBK) + ((size_t)(b * 4096 + wlo)) * 512 + hd * 64);
    const char* Vgw = (const char*)((const u16*)(ws + WS_SBVT) + ((size_t)(b * 8 + hd) * 64) * 4096 + wlo);
    uint4 kk[7], vv[7];
#pragma unroll
    for (int j = 0; j < 7; ++j) {
      const int c = tid + 512 * j, row = c >> 3, ch = c & 7;
      kk[j] = (row < nkeys) ? *(const uint4*)(Kgw + (size_t)row * 1024 + ch * 16) : make_uint4(0, 0, 0, 0);
      const int dv = c / 56, vc = c - dv * 56;
      vv[j] = (vc * 8 < nkeys) ? *(const uint4*)(Vgw + (size_t)dv * 8192 + vc * 16) : make_uint4(0, 0, 0, 0);
    }
#pragma unroll
    for (int j = 0; j < 7; ++j) {
      const int c = tid + 512 * j, row = c >> 3, ch = c & 7;
      *(uint4*)(smem + SBW_KOFF + row * 128 + ((ch ^ ((row >> 1) & 7)) << 4)) = kk[j];
      const int dv = c / 56, vc = c - dv * 56;
      *(uint4*)(smem + SBW_VOFF + dv * SBW_VPITCH + vc * 16) = vv[j];
    }
  }
  __syncthreads();
  const int r0 = R0 + 32 * wave;
  const u16* Qg = (const u16*)(ws + WS_SBQ) + ((size_t)(b * 4096 + r0 + l31)) * 512 + hd * 64 + 8 * lh;
  const u16* Kg = (const u16*)(ws + WS_SBK) + ((size_t)(b * 4096 + l31)) * 512 + hd * 64 + 8 * lh;
  const u16* Vg = (const u16*)(ws + WS_SBVT) + ((size_t)(b * 8 + hd) * 64 + l31) * 4096 + 8 * lh;
  bf16x8 qf[4];
#pragma unroll
  for (int s = 0; s < 4; ++s) qf[s] = *(const bf16x8*)(Qg + 16 * s);
  f32x16 o[2];
#pragma unroll
  for (int d = 0; d < 2; ++d)
#pragma unroll
    for (int r = 0; r < 16; ++r) o[d][r] = 0.f;
  float carry = 0.f;
  auto tile = [&](const bf16x8 (&kf)[4], const bf16x8 (&vf)[2][2], bool diag) -> bool {
    f32x16 z;
#pragma unroll
    for (int r = 0; r < 16; ++r) z[r] = 0.f;
#pragma unroll
    for (int s = 0; s < 4; ++s) z = MFMA32(kf[s], qf[s], z);
    float lf[16], ls[16];
#pragma unroll
    for (int r = 0; r < 16; ++r) {
      const float zz = z[r];
      const float tt = __builtin_amdgcn_logf(1.f + __builtin_amdgcn_exp2f(-fabsf(zz)));
      lf[r] = -fmaxf(zz, 0.f) - tt;
      ls[r] = fminf(zz, 0.f) - tt;
      const bool masked = diag && !(crow(r, lh) < l31);
      if (masked) { lf[r] = 0.f; ls[r] = -INFINITY; }
    }
    float gs[4], pg[4];
#pragma unroll
    for (int g = 0; g < 4; ++g) { gs[g] = (lf[4 * g] + lf[4 * g + 1]) + (lf[4 * g + 2] + lf[4 * g + 3]); pg[g] = shfl_xor_f(gs[g], 32); }
    float so[4], spi[4];
    so[3] = 0.f; so[2] = gs[3]; so[1] = gs[3] + gs[2]; so[0] = so[1] + gs[1];
    spi[3] = pg[3]; spi[2] = pg[3] + pg[2]; spi[1] = spi[2] + pg[1]; spi[0] = spi[1] + pg[0];
    f32x16 a;
#pragma unroll
    for (int g = 0; g < 4; ++g) {
      const float spx = (g < 3) ? spi[g + 1] : 0.f;
      float base = carry + so[g] + (lh ? spx : spi[g]);
      a[4 * g + 3] = __builtin_amdgcn_exp2f(ls[4 * g + 3] + base); base += lf[4 * g + 3];
      a[4 * g + 2] = __builtin_amdgcn_exp2f(ls[4 * g + 2] + base); base += lf[4 * g + 2];
      a[4 * g + 1] = __builtin_amdgcn_exp2f(ls[4 * g + 1] + base); base += lf[4 * g + 1];
      a[4 * g + 0] = __builtin_amdgcn_exp2f(ls[4 * g + 0] + base);
    }
    carry += so[0] + gs[0] + spi[0];
#pragma unroll
    for (int s2 = 0; s2 < 2; ++s2) {
      uint4 w = make_uint4(pk_bf16(a[8 * s2], a[8 * s2 + 1]), pk_bf16(a[8 * s2 + 2], a[8 * s2 + 3]),
                           pk_bf16(a[8 * s2 + 4], a[8 * s2 + 5]), pk_bf16(a[8 * s2 + 6], a[8 * s2 + 7]));
      const bf16x8 pf = __builtin_bit_cast(bf16x8, w);
#pragma unroll
      for (int db = 0; db < 2; ++db) o[db] = MFMA32(vf[db][s2], pf, o[db]);
    }
    return __all(carry <= -151.f);
  };
  bool done = false;
#pragma unroll 1
  for (int k0 = r0; k0 >= wlo; k0 -= 32) {
    const int kr = k0 - wlo;
    bf16x8 kf[4], vf[2][2];
#pragma unroll
    for (int s = 0; s < 4; ++s) {
      const int r = kr + l31;
      kf[s] = *(const bf16x8*)(smem + SBW_KOFF + r * 128 + (((2 * s + lh) ^ ((r >> 1) & 7)) << 4));
    }
#pragma unroll
    for (int db = 0; db < 2; ++db)
#pragma unroll
      for (int s2 = 0; s2 < 2; ++s2) vf[db][s2] = *(const bf16x8*)(smem + SBW_VOFF + (db * 32 + l31) * SBW_VPITCH + (kr + 16 * s2 + 8 * lh) * 2);
    done = tile(kf, vf, k0 == r0);
    if (done) break;
  }
  if (!done && wlo > 0) {
#pragma unroll 1
    for (int k0 = wlo - 32; k0 >= 0; k0 -= 32) {
      bf16x8 kf[4], vf[2][2];
#pragma unroll
      for (int s = 0; s < 4; ++s) kf[s] = *(const bf16x8*)(Kg + (size_t)k0 * 512 + 16 * s);
#pragma unroll
      for (int db = 0; db < 2; ++db)
#pragma unroll
        for (int s2 = 0; s2 < 2; ++s2) vf[db][s2] = *(const bf16x8*)(Vg + (size_t)db * 32 * 4096 + k0 + 16 * s2);
      if (tile(kf, vf, false)) break;
    }
  }
  const int t = b * 4096 + r0 + l31;
  u16* dst = (u16*)(ws + WS_SBO) + (size_t)t * 512 + hd * 64;
#pragma unroll
  for (int db = 0; db < 2; ++db)
#pragma unroll
    for (int g = 0; g < 4; ++g) {
      const f32x16& a = o[db];
      *(uint2*)(dst + db * 32 + 8 * g + 4 * lh) = make_uint2(pk_bf16(a[4 * g], a[4 * g + 1]), pk_bf16(a[4 * g + 2], a[4 * g + 3]));
    }
  __syncthreads();
}

DI void phase_attn(const Params& p, char* smem) {
  const int xcd = VXCD, cu = VCU, ncu = gridDim.x >> 3;
  float gq = 0.f, gk = 0.f;
  for (int i = 0; i < 96; ++i) { gq = fmaxf(gq, fabsf(p.q_norm[i])); gk = fmaxf(gk, fabsf(p.k_norm[i])); }
  const float Mb = __int_as_float(__builtin_amdgcn_readfirstlane(__float_as_int(9.797958971132712f * 1.4426950408889634f * gq * gk * 1.01f)));
  for (int w = cu; w < 16 * 4; w += ncu) {
    const int bh = (w / 4) * 8 + xcd, c = w % 4;
#pragma unroll 1
    for (int hf = 0; hf < 2; ++hf) { mla_attn_block512(p, smem, bh >> 3, bh & 7, hf ? c : 7 - c, Mb); __syncthreads(); }
  }
  for (int w = blockIdx.x; w < 256; w += gridDim.x) {
    const int bh = w >> 1, half = w & 1;
#pragma unroll 1
    for (int i = 0; i < 8; ++i) sb_attn_block256(p, smem, bh >> 3, bh & 7, half * 2048 + i * 256);
  }
}
template <int CTRL> DI float dpp_mov(float x) {
  return __uint_as_float(__builtin_amdgcn_update_dpp(0, __float_as_uint(x), CTRL, 0xf, 0xf, true));
}
typedef GemmStream<2, 4, 2, 2, 3, 2> G4;
DI void phase_outproj(const Params& p, char* smem) {
  char* ws = p.ws;
  const int tid = opaque_tid(), lane = tid & 63, wave = tid >> 6;
  const int wp = wave / 4, wq = wave % 4, l31 = lane & 31, lh = lane >> 5;
  const int xcd = VXCD, cu = VCU, ncu = gridDim.x >> 3;
  G4 gs; gs.init(smem, 512, 1024);
  auto seg = [&](int w2) { const int w = w2 >> 1, h = w2 & 1; Seg s; s.P = (const u16*)(ws + (h ? WS_MLAO : WS_SBO)) + (size_t)((w / 4) * 8 + xcd) * 128 * 512;
                           s.Q = (const u16*)(ws + WS_WOT) + (size_t)(w % 4) * 256 * 1024 + h * 512; s.nk = 8; return s; };
  Seg c0 = seg(2 * cu);
  gs.prologue(c0);
  for (int w = cu; w < 64 * 4; w += ncu) {
    const int tt = (w / 4) * 8 + xcd, nt = w % 4;
    const Seg c1 = seg(2 * w + 1);
    const Seg n0 = (w + ncu < 64 * 4) ? seg(2 * (w + ncu)) : c0;
    f32x16 acc0[2][2], acc1[2][2];
    float ss0[2], ss1[2];
    zero_acc(acc0); zero_acc(acc1);
    gs.run(acc0, ss0, c0, c1);
    gs.run(acc1, ss1, c1, n0);
    c0 = n0;
    const int q = lane & 3;
    const bool odd = (q & 1) != 0, hi = (q & 2) != 0;
#pragma unroll
    for (int pb = 0; pb < 2; ++pb) {
      const float r0 = rsqrtf(ss0[pb] * (1.f / 512.f) + 1e-6f), r1 = rsqrtf(ss1[pb] * (1.f / 512.f) + 1e-6f);
#pragma unroll
      for (int g = 0; g < 4; ++g) {
        float s0[4], s1[4];
#pragma unroll
        for (int i = 0; i < 4; ++i) { s0[i] = __shfl(r0, 8 * g + 4 * lh + i, 64); s1[i] = __shfl(r1, 8 * g + 4 * lh + i, 64); }
        const size_t t = (size_t)tt * 128 + wp * 64 + pb * 32 + 8 * g + 4 * lh + q;
#pragma unroll
        for (int qb = 0; qb < 2; ++qb) {
          float a[4];
#pragma unroll
          for (int i = 0; i < 4; ++i) a[i] = s0[i] * acc0[pb][qb][4 * g + i] + s1[i] * acc1[pb][qb][4 * g + i];
          const float t01 = dpp_mov<0xB1>(odd ? a[0] : a[1]), t23 = dpp_mov<0xB1>(odd ? a[2] : a[3]);
          const float b0 = odd ? t01 : a[0], b1 = odd ? a[1] : t01, b2 = odd ? t23 : a[2], b3 = odd ? a[3] : t23;
          const float u0 = dpp_mov<0x4E>(hi ? b0 : b2), u1 = dpp_mov<0x4E>(hi ? b1 : b3);
          const float c0 = hi ? u0 : b0, c1 = hi ? u1 : b1, c2 = hi ? b2 : u0, c3 = hi ? b3 : u1;
          const int n = nt * 256 + wq * 64 + qb * 32 + (l31 & ~3);
          const float4 xv = *(const float4*)(p.x + t * 1024 + n);
          const float4 o = make_float4(xv.x + c0, xv.y + c1, xv.z + c2, xv.w + c3);
          *(uint2*)((u16*)(ws + WS_XB) + t * 1024 + n) = make_uint2(pk_bf16(o.x, o.y), pk_bf16(o.z, o.w));
        }
      }
    }
  }
  gs.drain();
}

DI int f2key(float f) { const int b = __float_as_int(f); return b ^ ((b >> 31) & 0x7fffffff); }
DI float key2f(int k) { return __int_as_float(k ^ ((k >> 31) & 0x7fffffff)); }
#define CE_D(a, b) { const int _mx = max(a, b), _mn = min(a, b); a = _mx; b = _mn; }
template <int N, int OFF>
DI void bitonic_sort_desc(int (&v)[64]) {
#pragma unroll
  for (int k = 2; k <= N; k <<= 1)
#pragma unroll
    for (int j = k >> 1; j > 0; j >>= 1)
#pragma unroll
      for (int i = 0; i < N; ++i) {
        const int l = i ^ j;
        if (l > i) {
          if ((i & k) == 0 || k == N) { CE_D(v[OFF + i], v[OFF + l]); } else { CE_D(v[OFF + l], v[OFF + i]); }
        }
      }
}
DI void bitonic_merge16_desc(int (&v)[16]) {
#pragma unroll
  for (int j = 8; j > 0; j >>= 1)
#pragma unroll
    for (int i = 0; i < 16; ++i) { const int l = i ^ j; if (l > i) { CE_D(v[i], v[l]); } }
}
DI void top16_of_64(int (&v)[64], int (&out)[16]) {
  bitonic_sort_desc<16, 0>(v); bitonic_sort_desc<16, 16>(v); bitonic_sort_desc<16, 32>(v); bitonic_sort_desc<16, 48>(v);
  int a[16], b[16];
#pragma unroll
  for (int i = 0; i < 16; ++i) { a[i] = max(v[i], v[31 - i]); b[i] = max(v[32 + i], v[63 - i]); }
  bitonic_merge16_desc(a); bitonic_merge16_desc(b);
#pragma unroll
  for (int i = 0; i < 16; ++i) out[i] = max(a[i], b[15 - i]);
  bitonic_merge16_desc(out);
}

typedef GemmStream<2, 4, 4, 2, 2, 1> G5;
#define P5_SUBK_OFF 0
#define P5_LIST_OFF 65536
DI void peer_query_tile(const Params& p, char* smem, int tt, int hd) {
  char* ws = p.ws;
  const int tid = opaque_tid(), lane = tid & 63, wave = tid >> 6;
  const int wp = wave / 4, wq = wave % 4, l31 = lane & 31, lh = lane >> 5;
  float ssq[2];
  f32x16 acc[4][2];
  zero_acc(acc);
  {
    G5 gs; gs.init(smem, 1024, 1024);
    Seg cur; cur.P = (const u16*)(ws + WS_WPQT) + (size_t)hd * 256 * 1024; cur.Q = (const u16*)(ws + WS_XB) + (size_t)tt * 256 * 1024; cur.nk = 16;
    gs.prologue(cur);
    gs.run(acc, ssq, cur, cur);
    gs.drain();
  }
  {
    const uint4* src0 = (const uint4*)((const u16*)(ws + WS_SUBK) + (size_t)(0 * 8 + hd) * 128 * 128);
    const uint4* src1 = (const uint4*)((const u16*)(ws + WS_SUBK) + (size_t)(1 * 8 + hd) * 128 * 128);
#pragma unroll
    for (int i = 0; i < 4; ++i) {
      const int ch = tid + i * 512;
      const int key = ch >> 4, cc = ch & 15;
      const int off = key * 256 + ((cc ^ (key & 15)) << 4);
      *(uint4*)(smem + P5_SUBK_OFF + off) = src0[ch];
      *(uint4*)(smem + P5_SUBK_OFF + 32768 + off) = src1[ch];
    }
  }
  __syncthreads();
  const char* sk = smem + P5_SUBK_OFF + wp * 32768;
  int* lists = (int*)(smem + P5_LIST_OFF);
  bf16x8 xf[2][8];
#pragma unroll
  for (int qb = 0; qb < 2; ++qb) {
    const float r2 = rsqrtf(ssq[qb] * (1.f / 1024.f) + 1e-6f);
#pragma unroll
    for (int pb = 0; pb < 4; ++pb)
#pragma unroll
      for (int s2 = 0; s2 < 2; ++s2) {
        const f32x16& a = acc[pb][qb];
        uint4 w = make_uint4(pk_bf16(a[8 * s2] * r2, a[8 * s2 + 1] * r2), pk_bf16(a[8 * s2 + 2] * r2, a[8 * s2 + 3] * r2),
                             pk_bf16(a[8 * s2 + 4] * r2, a[8 * s2 + 5] * r2), pk_bf16(a[8 * s2 + 6] * r2, a[8 * s2 + 7] * r2));
        xf[qb][pb * 2 + s2] = __builtin_bit_cast(bf16x8, w);
      }
  }
#pragma unroll
  for (int qb = 0; qb < 2; ++qb) {
    const int tl = wq * 64 + qb * 32 + l31;
    int keys[64];
#pragma unroll
    for (int kb = 0; kb < 4; ++kb) {
      f32x16 sc;
#pragma unroll
      for (int r = 0; r < 16; ++r) sc[r] = 0.f;
      const int key = kb * 32 + l31;
#pragma unroll
      for (int kk = 0; kk < 8; ++kk) {
        const bf16x8 af = *(const bf16x8*)(sk + key * 256 + (((2 * kk + lh) ^ (key & 15)) << 4));
        sc = MFMA32(af, xf[qb][kk], sc);
      }
#pragma unroll
      for (int r = 0; r < 16; ++r) {
        const int n = kb * 32 + crow(r, lh);
        keys[kb * 16 + r] = f2key(__int_as_float((__float_as_int(sc[r]) & ~127) | n));
      }
    }
    int top[16];
    top16_of_64(keys, top);
    int mrg[16];
#pragma unroll
    for (int i = 0; i < 16; ++i) mrg[i] = __shfl_xor(top[15 - i], 32, 64);
#pragma unroll
    for (int i = 0; i < 16; ++i) mrg[i] = max(mrg[i], top[i]);
    bitonic_merge16_desc(mrg);
    if (lh == 0) {
      int* dst = lists + (wp * 256 + tl) * 16;
#pragma unroll
      for (int g = 0; g < 4; ++g) *(int4*)(dst + 4 * g) = make_int4(mrg[4 * g], mrg[4 * g + 1], mrg[4 * g + 2], mrg[4 * g + 3]);
    }
  }
  __syncthreads();
  if (tid < 256) {
    const int* la = lists + tid * 16;
    const int* lb = lists + (256 + tid) * 16;
    float av[16], bv[16];
#pragma unroll
    for (int i = 0; i < 16; ++i) {
      av[i] = __int_as_float(__float_as_int(key2f(la[i])) & ~127);
      bv[i] = __int_as_float(__float_as_int(key2f(lb[i])) & ~127);
    }
    int cand[64];
    int nc = 0;
#pragma unroll
    for (int i = 0; i < 16; ++i)
#pragma unroll
      for (int j = 0; j < 16; ++j)
        if ((i + 1) * (j + 1) <= 16) {
          const float s = av[i] + bv[j];
          cand[nc] = f2key(__int_as_float((__float_as_int(s) & ~255) | (i * 16 + j)));
          ++nc;
        }
#pragma unroll
    for (int i = 50; i < 64; ++i) cand[i] = (int)0x80000000;
    int best[16];
    top16_of_64(cand, best);
    float sv[16], den = 0.f;
    int ex[16];
    const float smax = key2f(best[0]);
#pragma unroll
    for (int k = 0; k < 16; ++k) {
      const float s = key2f(best[k]);
      const int id = __float_as_int(s) & 255;
      const int n1 = __float_as_int(key2f(la[id >> 4])) & 127;
      const int n2 = __float_as_int(key2f(lb[id & 15])) & 127;
      ex[k] = n1 * 128 + n2;
      sv[k] = __expf(s - smax);
      den += sv[k];
    }
    const float inv = 1.f / den;
    const size_t t = (size_t)tt * 256 + tid;
    int* di = (int*)(ws + WS_IDX) + t * 128 + hd * 16;
    float* dg = (float*)(ws + WS_GATE) + t * 128 + hd * 16;
#pragma unroll
    for (int g = 0; g < 4; ++g) {
      *(int4*)(di + 4 * g) = make_int4(ex[4 * g], ex[4 * g + 1], ex[4 * g + 2], ex[4 * g + 3]);
      *(float4*)(dg + 4 * g) = make_float4(sv[4 * g] * inv, sv[4 * g + 1] * inv, sv[4 * g + 2] * inv, sv[4 * g + 3] * inv);
    }
  }
  __syncthreads();
}
DI void phase_peerq(const Params& p, char* smem) {
  const int xcd = VXCD, cu = VCU, ncu = gridDim.x >> 3;
  for (int w = cu; w < 32 * 8; w += ncu) peer_query_tile(p, smem, (w / 8) * 8 + xcd, w % 8);
}

DI float4 bf16x4_to_f32(uint2 w) { return make_float4(__uint_as_float(w.x << 16), __uint_as_float(w.x & 0xffff0000u), __uint_as_float(w.y << 16), __uint_as_float(w.y & 0xffff0000u)); }
DI float wave_sum(float v) {
  v += shfl_xor_f(v, 32); v += shfl_xor_f(v, 16); v += shfl_xor_f(v, 8); v += shfl_xor_f(v, 4); v += shfl_xor_f(v, 2); v += shfl_xor_f(v, 1);
  return v;
}
DI float reduce8(const float (&d)[8], int lane) {
  float r1[4], r2[2];
#pragma unroll
  for (int m = 0; m < 4; ++m) {
    auto r = __builtin_amdgcn_permlane32_swap(__float_as_uint(d[m]), __float_as_uint(d[m + 4]), false, false);
    r1[m] = __uint_as_float(r[0]) + __uint_as_float(r[1]);
  }
#pragma unroll
  for (int m = 0; m < 2; ++m) {
    auto r = __builtin_amdgcn_permlane16_swap(__float_as_uint(r1[m]), __float_as_uint(r1[m + 2]), false, false);
    r2[m] = __uint_as_float(r[0]) + __uint_as_float(r[1]);
  }
  const bool b3 = (lane & 8) != 0;
  const float keep = b3 ? r2[1] : r2[0], send = b3 ? r2[0] : r2[1];
  float s = keep + dpp_mov<0x128>(send);
  s += dpp_mov<0x141>(s);
  s += dpp_mov<0xB1>(s);
  s += dpp_mov<0x4E>(s);
  return s;
}
template <int CTRL> DI int dpp_movi(int x) { return __builtin_amdgcn_update_dpp(0, x, CTRL, 0xf, 0xf, true); }
DI int reduce8i(const int (&d)[8], int lane) {
  int r1[4], r2[2];
#pragma unroll
  for (int m = 0; m < 4; ++m) {
    auto r = __builtin_amdgcn_permlane32_swap((u32)d[m], (u32)d[m + 4], false, false);
    r1[m] = (int)(r[0] + r[1]);
  }
#pragma unroll
  for (int m = 0; m < 2; ++m) {
    auto r = __builtin_amdgcn_permlane16_swap((u32)r1[m], (u32)r1[m + 2], false, false);
    r2[m] = (int)(r[0] + r[1]);
  }
  const bool b3 = (lane & 8) != 0;
  const int keep = b3 ? r2[1] : r2[0], send = b3 ? r2[0] : r2[1];
  int s = keep + dpp_movi<0x128>(send);
  s += dpp_movi<0x141>(s);
  s += dpp_movi<0xB1>(s);
  s += dpp_movi<0x4E>(s);
  return s;
}
DI float wave_max(float v) {
  v = fmaxf(v, shfl_xor_f(v, 32)); v = fmaxf(v, shfl_xor_f(v, 16)); v = fmaxf(v, shfl_xor_f(v, 8));
  v = fmaxf(v, shfl_xor_f(v, 4)); v = fmaxf(v, shfl_xor_f(v, 2)); v = fmaxf(v, shfl_xor_f(v, 1));
  return v;
}
DI u32 pack_i8x4(float a, float b, float c, float d) {
  const int ia = __float2int_rn(a), ib = __float2int_rn(b), ic = __float2int_rn(c), id = __float2int_rn(d);
  return ((u32)ia & 255u) | (((u32)ib & 255u) << 8) | (((u32)ic & 255u) << 16) | ((u32)id << 24);
}
DI float gelu_erf(float x) {
  const float z = fabsf(x) * 0.7071067811865476f;
  const float t = __builtin_amdgcn_rcpf(1.f + 0.3275911f * z);
  const float poly = t * (0.254829592f + t * (-0.284496736f + t * (1.421413741f + t * (-1.453152027f + t * 1.061405429f))));
  const float e = 1.f - poly * __builtin_amdgcn_exp2f(-z * z * 1.4426950408889634f);
  return 0.5f * x * (1.f + copysignf(e, x));
}
typedef unsigned v3u __attribute__((ext_vector_type(3)));
typedef unsigned v4u __attribute__((ext_vector_type(4)));
typedef unsigned v6u __attribute__((ext_vector_type(6)));
typedef float v32f __attribute__((ext_vector_type(32)));
DI v32f cvt_rows(const uint3& ra, const uint3& rb, u32 z) {
  v6u w; w[0] = ra.x; w[1] = ra.y; w[2] = ra.z; w[3] = rb.x | z; w[4] = rb.y | z; w[5] = rb.z | z;
  return __builtin_amdgcn_cvt_scalef32_pk32_f32_fp6(w, 1.0f);
}
DI void axpy_rows(const uint3& ra, const uint3& rb, u32 z, float ca, float cb, f32x2 (&acc)[8]) {
  const v32f f = cvt_rows(ra, rb, z);
  const f32x2 ca2 = {ca, ca}, cb2 = {cb, cb};
#pragma unroll
  for (int m = 0; m < 8; ++m) {
    acc[m] = ca2 * f32x2{f[2 * m], f[2 * m + 1]} + acc[m];
    acc[m] = cb2 * f32x2{f[16 + 2 * m], f[17 + 2 * m]} + acc[m];
  }
}
#ifndef P6_PACE
#define P6_PACE 1
#endif
#ifndef P6_GROUP_PACE
#define P6_GROUP_PACE 0
#endif
#ifndef P6_YOUNG_PRIO
#define P6_YOUNG_PRIO 0
#endif
#define P6_ENT_E 0
#define P6_ENT_C 2048
#define P6_ENT_G 4096
#define P6_CNT   6144
#define P6_WAVE_BYTES 6400
DI void xcd_group_pace(unsigned* cnt, unsigned target) {
  if ((opaque_tid() & (NTHREADS - 1)) == 0) {
    __hip_atomic_fetch_add(cnt, 1u, __ATOMIC_RELAXED, __HIP_MEMORY_SCOPE_AGENT);
    for (int sp = 0; sp < 4000; ++sp) {
      if (__hip_atomic_load(cnt, __ATOMIC_RELAXED, __HIP_MEMORY_SCOPE_AGENT) >= target) break;
      __builtin_amdgcn_s_sleep(8);
    }
  }
  __syncthreads();
}
DI void phase_experts(const Params& p, char* smem) {
  char* ws = p.ws;
  const int wave = opaque_tid() >> 6;
  const int xcd = VXCD, cu = VCU, ncu = gridDim.x >> 3;
  const __amdgpu_buffer_rsrc_t U8 = __builtin_amdgcn_make_buffer_rsrc((void*)(ws + WS_UB), 0, 16 << 20, 0x00020000);
  const __amdgpu_buffer_rsrc_t V8 = __builtin_amdgcn_make_buffer_rsrc((void*)(ws + WS_VB), 0, 16 << 20, 0x00020000);
  const float* usc = (const float*)(ws + WS_USC);
  const float* vsc = (const float*)(ws + WS_VSC);
  char* wl = smem + wave * P6_WAVE_BYTES;
  u32* ent_e = (u32*)(wl + P6_ENT_E);
  float* ent_c = (float*)(wl + P6_ENT_C);
  float* ent_g = (float*)(wl + P6_ENT_G);
  int* cnt = (int*)(wl + P6_CNT);
  const int tok_per_round = ncu * 32;
  unsigned* pace = (unsigned*)(ws + WS_END + 49152) + 64 * xcd;
  unsigned pace_n = 0;
  const int tok_per_xcd = NTOK / 8;
#ifdef P6_STAMP
  unsigned long long ts[5] = {0, 0, 0, 0, 0};
#define P6_T(i) do { __builtin_amdgcn_sched_barrier(0); unsigned long long _t; asm volatile("s_waitcnt vmcnt(0) lgkmcnt(0)\n\ts_memtime %0\n\ts_waitcnt lgkmcnt(0)" : "=s"(_t) :: "memory"); ts[i] += _t - tprev; tprev = _t; __builtin_amdgcn_sched_barrier(0); } while (0)
  unsigned long long tprev; asm volatile("s_memtime %0\n\ts_waitcnt lgkmcnt(0)" : "=s"(tprev) :: "memory");
#else
#define P6_T(i) do { } while (0)
#endif
  int e_n[4][2];
  float gt_n[4][2], us_n[4][2], vs_n[4][2];
  auto prefetch_idx = [&](int t0n) {
    const int ln = opaque_tid() & 63;
#pragma unroll
    for (int k = 0; k < 4; ++k) {
      const int* idx = (const int*)(ws + WS_IDX) + (size_t)(t0n + k) * 128;
      const float* gate = (const float*)(ws + WS_GATE) + (size_t)(t0n + k) * 128;
#pragma unroll
      for (int h = 0; h < 2; ++h) { e_n[k][h] = idx[64 * h + ln]; gt_n[k][h] = gate[64 * h + ln]; }
    }
  };
  auto prefetch_sc = [&]() {
#pragma unroll
    for (int k = 0; k < 4; ++k)
#pragma unroll
      for (int h = 0; h < 2; ++h) { us_n[k][h] = usc[e_n[k][h]]; vs_n[k][h] = vsc[e_n[k][h]]; }
  };
  prefetch_idx(xcd * tok_per_xcd + cu * 32 + wave * 4);
  prefetch_sc();
#if P6_YOUNG_PRIO
  if (__builtin_amdgcn_readfirstlane(wave) >= 4) __builtin_amdgcn_s_setprio(1);
#endif
#pragma unroll 1
  for (int rb = cu * 32; rb < tok_per_xcd; rb += tok_per_round) {
    const int t0 = xcd * tok_per_xcd + rb + wave * 4;
    const int lane = opaque_tid() & 63;
    const unsigned lane_off = lane * 12;
    u32 zero; asm volatile("s_mov_b32 %0, 0" : "=s"(zero));
    const int jq = 128 * ((lane & 7) >> 1) + (lane & 1);
    const int jr = 128 * ((lane >> 3) >> 1) + ((lane >> 3) & 1);
    u32 xq[4][4];
    float r2[4];
#pragma unroll
    for (int k = 0; k < 4; ++k) {
      const u16* xrow = (const u16*)(ws + WS_XB) + (size_t)(t0 + k) * 1024 + 4 * lane;
      float4 a[4];
      float ss = 0.f, mx = 0.f;
#pragma unroll
      for (int i = 0; i < 4; ++i) {
        a[i] = bf16x4_to_f32(*(const uint2*)(xrow + 256 * i));
        ss += a[i].x * a[i].x + a[i].y * a[i].y + a[i].z * a[i].z + a[i].w * a[i].w;
        mx = fmaxf(mx, fmaxf(fmaxf(fabsf(a[i].x), fabsf(a[i].y)), fmaxf(fabsf(a[i].z), fabsf(a[i].w))));
      }
      ss = wave_sum(ss);
      mx = wave_max(mx);
      const float qs = (mx > 0.f) ? 127.f / mx : 1.f;
#pragma unroll
      for (int i = 0; i < 4; ++i) xq[k][i] = pack_i8x4(a[i].x * qs, a[i].y * qs, a[i].z * qs, a[i].w * qs);
      r2[k] = rsqrtf(ss * (1.f / 1024.f) + 1e-6f) * ((mx > 0.f) ? mx * (1.f / 127.f) : 1.f);
    }
    P6_T(0);
    cnt[lane] = 0;
    {
      int e_[4][2], pos_[4][2];
      float c_[4][2], g_[4][2];
#pragma unroll
      for (int k = 0; k < 4; ++k) {
#pragma unroll
        for (int h = 0; h < 2; ++h) {
          const int e = e_n[k][h];
          e_[k][h] = e;
          c_[k][h] = r2[k] * us_n[k][h];
          g_[k][h] = gt_n[k][h] * vs_n[k][h];
          pos_[k][h] = atomicAdd(&cnt[k * 16 + (e >> 10)], 1);
        }
      }
      const int c = cnt[lane];
      int incl = c;
#pragma unroll
      for (int d = 1; d < 64; d <<= 1) { const int v = __shfl_up(incl, d, 64); if (lane >= d) incl += v; }
      cnt[lane] = incl - c;
#pragma unroll
      for (int k = 0; k < 4; ++k)
#pragma unroll
        for (int h = 0; h < 2; ++h) {
          const int e = e_[k][h];
          const int q = cnt[k * 16 + (e >> 10)] + pos_[k][h];
          ent_e[q] = (u32)e;
          ent_c[q] = c_[k][h];
          ent_g[q] = g_[k][h];
        }
    }
    P6_T(1);
    {
      uint4 ra[8], rb8[8], rc8[8];
      auto issue = [&](int g_, uint4 (&rr)[8]) {
        const int g = (g_ < 64) ? g_ : 63;
        const u32 ev = ent_e[jq + 2 * g] << 10;
#pragma unroll
        for (int j = 0; j < 8; ++j) {
          const v4u w = __builtin_amdgcn_raw_buffer_load_b128(U8, lane * 16, (u32)__builtin_amdgcn_readlane((int)ev, j), 0);
          rr[j] = make_uint4(w.x, w.y, w.z, w.w);
        }
        __builtin_amdgcn_sched_barrier(0);
      };
      auto compute_u = [&](int g, const uint4 (&rr)[8]) {
        int d[8];
#pragma unroll
        for (int j = 0; j < 8; ++j) {
          int a = __builtin_amdgcn_sdot4((int)rr[j].x, (int)xq[j >> 1][0], 0, false);
          a = __builtin_amdgcn_sdot4((int)rr[j].y, (int)xq[j >> 1][1], a, false);
          a = __builtin_amdgcn_sdot4((int)rr[j].z, (int)xq[j >> 1][2], a, false);
          d[j] = __builtin_amdgcn_sdot4((int)rr[j].w, (int)xq[j >> 1][3], a, false);
        }
        const int tot = reduce8i(d, lane);
        const int q = jr + 2 * g;
        const float pre = (float)tot * ent_c[q];
        const float cf = ent_g[q] * gelu_erf(pre);
        if ((lane & 7) == 0) ent_c[q] = cf;
      };
      issue(0, ra); issue(1, rb8);
#pragma unroll 1
      for (int g = 0; g < 63; g += 3) {
        issue(g + 2, rc8); compute_u(g, ra);
        issue(g + 3, ra);  compute_u(g + 1, rb8);
        issue(g + 4, rb8); compute_u(g + 2, rc8);
        if (P6_PACE && g == 30) __syncthreads();
      }
      compute_u(63, ra);
      if (P6_PACE) __syncthreads();
    }
    P6_T(2);
    uint3 ra[8], rb8[8];
    auto issue = [&](__amdgpu_buffer_rsrc_t tab, int g_, uint3 (&rr)[8]) {
      const int g = (g_ < 64) ? g_ : 63;
      const u32 ev = ent_e[jq + 2 * g] * 768u;
#pragma unroll
      for (int j = 0; j < 8; ++j) {
        const v3u w = __builtin_amdgcn_raw_buffer_load_b96(tab, lane_off, (u32)__builtin_amdgcn_readlane((int)ev, j), 0);
        rr[j] = make_uint3(w.x, w.y, w.z);
      }
      __builtin_amdgcn_sched_barrier(0);
    };
    f32x2 acc[4][8];
#pragma unroll
    for (int k = 0; k < 4; ++k)
#pragma unroll
      for (int i = 0; i < 8; ++i) acc[k][i] = f32x2{0.f, 0.f};
    auto compute_v = [&](int g, const uint3 (&rr)[8]) {
      const float cl = ent_c[jq + 2 * g];
#pragma unroll
      for (int k = 0; k < 4; ++k)
        axpy_rows(rr[2 * k], rr[2 * k + 1], zero, __int_as_float(__builtin_amdgcn_readlane(__float_as_int(cl), 2 * k)),
                  __int_as_float(__builtin_amdgcn_readlane(__float_as_int(cl), 2 * k + 1)), acc[k]);
    };
#if P6_GROUP_PACE
    xcd_group_pace(pace, (++pace_n) * ncu);
#endif
    {
      const int rbn = (rb + tok_per_round < tok_per_xcd) ? rb + tok_per_round : rb;
      prefetch_idx(xcd * tok_per_xcd + rbn + wave * 4);
    }
    issue(V8, 0, ra);
#pragma unroll 1
    for (int g = 0; g < 64; g += 2) {
      issue(V8, g + 1, rb8); compute_v(g, ra);
      issue(V8, g + 2, ra);  compute_v(g + 1, rb8);
      if (P6_PACE && (g & 30) == 30) __syncthreads();
    }
    prefetch_sc();
    P6_T(3);
#pragma unroll
    for (int k = 0; k < 4; ++k) {
      float* orow = p.out + (size_t)(t0 + k) * 1024 + 4 * lane;
      const u16* xrow = (const u16*)(ws + WS_XB) + (size_t)(t0 + k) * 1024 + 4 * lane;
#pragma unroll
      for (int i = 0; i < 4; ++i) {
        const float4 a = bf16x4_to_f32(*(const uint2*)(xrow + 256 * i));
        *(float4*)(orow + 256 * i) = make_float4(a.x + acc[k][2 * i][0], a.y + acc[k][2 * i][1], a.z + acc[k][2 * i + 1][0], a.w + acc[k][2 * i + 1][1]);
      }
    }
    P6_T(4);
  }
#if P6_YOUNG_PRIO
  __builtin_amdgcn_s_setprio(0);
#endif
#ifdef P6_STAMP
  if (blockIdx.x == P6_STAMP_BLK && wave == P6_STAMP_WAVE && (opaque_tid() & 63) == 0) {
    unsigned long long* d = (unsigned long long*)(ws + WS_END + 32768);
    for (int i = 0; i < 5; ++i) d[i] = ts[i];
  }
#endif
}

#define XB_TMO      128
#define XB_XCNT(j)  (256  + 64 * (j))
#define XB_XSUB(j)  (1280 + 64 * (j))
#define XB_XGEN(j)  (2304 + 64 * (j))
#define XB_TOP      3328
#define XB_TOPGEN   3392
#define XCD_BAR_WORDS 3456
#define XB_SPIN_CAP (1u << 20)
#define LAS __attribute__((address_space(3)))
DI unsigned xb_ld(unsigned* p) { return __hip_atomic_load(p, __ATOMIC_RELAXED, __HIP_MEMORY_SCOPE_AGENT); }
DI unsigned xb_add(unsigned* p, unsigned v) { return __hip_atomic_fetch_add(p, v, __ATOMIC_RELAXED, __HIP_MEMORY_SCOPE_AGENT); }
DI unsigned xb_xcc_id() { return (unsigned)__builtin_amdgcn_s_getreg((3 << 11) | 20) & 0xFu; }
#define XB_SPIN(cond, bar) do { unsigned _sp = 0; while (cond) { __builtin_amdgcn_s_sleep(1); \
    if ((++_sp & 255u) == 0u) { if (xb_ld(&(bar)[XB_TMO])) break; if (_sp > XB_SPIN_CAP) { atomicAdd(&(bar)[XB_TMO], 1u); break; } } } } while (0)
struct XcdBarrier { unsigned* bar; unsigned x; volatile LAS unsigned* st; };
DI XcdBarrier xcd_barrier_post(unsigned* bar, volatile LAS unsigned* st) {
  XcdBarrier b; b.bar = bar; b.x = xb_xcc_id(); b.st = st;
  if (threadIdx.x == 0) (void)xb_add(&bar[XB_XCNT(b.x)], 1u);
  return b;
}
DI void xcd_barrier_complete(unsigned* bar, unsigned x, unsigned& nloc, unsigned& nx) {
  const unsigned G = gridDim.x * gridDim.y * gridDim.z;
  unsigned sum, cnt, mine, sp = 0u;
  for (;;) {
    sum = 0u; cnt = 0u; mine = 0u;
#pragma unroll
    for (unsigned j = 0; j < 16; ++j) { const unsigned c = xb_ld(&bar[XB_XCNT(j)]); sum += c; cnt += (c > 0u) ? 1u : 0u; mine = (j == x) ? c : mine; }
    if (sum == G) break;
    __builtin_amdgcn_s_sleep(1);
    if ((++sp & 255u) == 0u) { if (xb_ld(&bar[XB_TMO])) break; if (sp > XB_SPIN_CAP) { atomicAdd(&bar[XB_TMO], 1u); break; } }
  }
  nloc = mine > 0u ? mine : 1u; nx = cnt > 0u ? cnt : 1u;
}
DI void xcd_barrier(const XcdBarrier& b) {
  asm volatile("s_waitcnt vmcnt(0)" ::: "memory");
  __syncthreads();
  if (threadIdx.x == 0) {
    unsigned* bar = b.bar;
    __builtin_amdgcn_s_waitcnt(0);
    unsigned nloc = b.st[0], nx = b.st[1];
    if (nloc == 0u) { xcd_barrier_complete(bar, b.x, nloc, nx); b.st[0] = nloc; b.st[1] = nx; }
    const unsigned old = xb_add(&bar[XB_XSUB(b.x)], 1u);
    const unsigned gen = old / nloc;
    if (old + 1u == (gen + 1u) * nloc) {
      __builtin_amdgcn_fence(__ATOMIC_RELEASE, "agent");
      asm volatile("s_waitcnt vmcnt(0)" ::: "memory");
      const unsigned og = xb_add(&bar[XB_TOP], 1u);
      const unsigned tg = og / nx;
      if (og + 1u == (tg + 1u) * nx) xb_add(&bar[XB_TOPGEN], 1u);
      else XB_SPIN(xb_ld(&bar[XB_TOPGEN]) == tg, bar);
      __builtin_amdgcn_fence(__ATOMIC_ACQUIRE, "agent");
      xb_add(&bar[XB_XGEN(b.x)], 1u);
      asm volatile("s_waitcnt vmcnt(0)" ::: "memory");
    } else {
      XB_SPIN(xb_ld(&bar[XB_XGEN(b.x)]) == gen, bar);
      __builtin_amdgcn_fence(__ATOMIC_ACQUIRE, "agent");
      asm volatile("s_waitcnt vmcnt(0)" ::: "memory");
    }
  }
  __syncthreads();
}

#define LDS_TOTAL 155648
#define LDS_ALLOC (LDS_TOTAL + 16)
#define WS_BAR WS_END
#define N_PHASES 7
#ifndef N_LAUNCH_SPLIT
#define N_LAUNCH_SPLIT 0
#endif
__global__ void __launch_bounds__(NTHREADS) mega_fwd(Params p) {
  extern __shared__ __attribute__((aligned(16))) char smem[];
  cg::grid_group grid = cg::this_grid();
  volatile LAS unsigned* xst = (volatile LAS unsigned*)(smem + LDS_TOTAL);
  if (threadIdx.x == 0) { xst[0] = 0u; xst[1] = 0u; xst[2] = 0u; xst[3] = 0u; }
  if (blockIdx.x == 0) for (int i = opaque_tid(); i < XCD_BAR_WORDS; i += NTHREADS) ((unsigned*)(p.ws + WS_BAR))[i] = 0u;
  __syncthreads();
  XcdBarrier xb; xb.bar = (unsigned*)(p.ws + WS_BAR); xb.x = 0; xb.st = xst;
#ifndef DOUBLE_MASK
#define DOUBLE_MASK 0
#endif
#define GRID_SYNC(k) do { if ((k) == 0) { __threadfence(); grid.sync(); xb = xcd_barrier_post((unsigned*)(p.ws + WS_BAR), xst); } else xcd_barrier(xb); } while (0)
#ifdef PH_STAMP
#define PH_MARK(k) do { if (blockIdx.x == 0 && threadIdx.x == 0) { const unsigned long long _t = __builtin_amdgcn_s_memrealtime(); ((unsigned long long*)(p.ws + WS_END + 40960))[k] = _t; } } while (0)
#else
#define PH_MARK(k) do { } while (0)
#endif
#if N_LAUNCH_SPLIT
#define RUN_PHASE(k, call) if (p.ph_lo <= (k) && (k) < p.ph_hi) { PH_MARK(k); call; if ((DOUBLE_MASK >> (k)) & 1) { GRID_SYNC(k); call; } if ((k) + 1 < p.ph_hi) GRID_SYNC(k); }
#else
#define RUN_PHASE(k, call) { PH_MARK(k); call; if ((DOUBLE_MASK >> (k)) & 1) { GRID_SYNC(k); call; } if ((k) + 1 < N_PHASES) GRID_SYNC(k); }
#endif
  RUN_PHASE(0, phase_prep(p, smem))
  RUN_PHASE(1, phase_inproj(p, smem))
  RUN_PHASE(2, phase_mlaproj(p, smem))
  RUN_PHASE(3, phase_attn(p, smem))
  RUN_PHASE(4, phase_outproj(p, smem))
  RUN_PHASE(5, phase_peerq(p, smem))
  RUN_PHASE(6, phase_experts(p, smem))
#ifdef PH_STAMP
  PH_MARK(7);
  xcd_barrier(xb);
  if (blockIdx.x == 0 && threadIdx.x == 0) {
    unsigned long long* d = (unsigned long long*)(p.ws + WS_END + 40960);
    d[8] = __builtin_amdgcn_s_memrealtime();
    p.out[0] += (float)((double)(d[PH_STAMP_B] - d[PH_STAMP_A]) * 0.00001 * PH_SCALE);
  }
#endif
#ifdef FP6_PROBE
  xcd_barrier(xb);
  if (blockIdx.x == 0 && threadIdx.x < 64) {
    typedef unsigned v6u_t __attribute__((ext_vector_type(6)));
    typedef float v32f_t __attribute__((ext_vector_type(32)));
    const int lane = threadIdx.x;
    unsigned w[7] = {0u, 0u, 0u, 0u, 0u, 0u, 0u};
    int bad = 0;
#pragma unroll
    for (int i = 0; i < 32; ++i) {
      const unsigned c = (unsigned)((i + 32 * (lane & 1)) & 63);
      const int off = 6 * i, wd = off >> 5, sh = off & 31;
      w[wd] |= c << sh;
      if (sh > 26) w[wd + 1] |= c >> (32 - sh);
    }
    v6u_t a; a[0] = w[0]; a[1] = w[1]; a[2] = w[2]; a[3] = w[3]; a[4] = w[4]; a[5] = w[5];
    const v32f_t r = __builtin_amdgcn_cvt_scalef32_pk32_f32_fp6(a, 1.0f);
#pragma unroll
    for (int i = 0; i < 32; ++i) {
      const int c = (i + 32 * (lane & 1)) & 63;
      const int e = (c >> 3) & 3, m = c & 7;
      float v = (e == 0) ? (float)m * 0.125f : (1.f + (float)m * 0.125f) * (float)(1 << (e - 1));
      if (c & 32) v = -v;
      if (r[i] != v) ++bad;
    }
    bad = __builtin_amdgcn_readfirstlane(bad) | __builtin_amdgcn_readlane(bad, 1);
    v32f_t r0 = r, r1 = r, r2, r3;
    unsigned long long t0, t1;
    asm volatile("s_waitcnt vmcnt(0) lgkmcnt(0)\n\ts_memtime %0\n\ts_waitcnt lgkmcnt(0)" : "=s"(t0) :: "memory");
#pragma unroll 1
    for (int it = 0; it < 256; ++it) {
#if FP6_PROBE == 1
      asm volatile("v_cvt_scalef32_pk32_f32_fp6 %0, %4, 1.0\n\tv_cvt_scalef32_pk32_f32_fp6 %1, %4, 1.0\n\tv_cvt_scalef32_pk32_f32_fp6 %2, %4, 1.0\n\tv_cvt_scalef32_pk32_f32_fp6 %3, %4, 1.0"
                   : "=v"(r0), "=v"(r1), "=v"(r2), "=v"(r3) : "v"(a));
#elif FP6_PROBE == 3
      asm volatile("v_fma_f32 %0, %2, %2, %0\n\tv_fma_f32 %1, %2, %2, %1\n\tv_fma_f32 %0, %2, %2, %0\n\tv_fma_f32 %1, %2, %2, %1\n\t"
                   "v_fma_f32 %0, %2, %2, %0\n\tv_fma_f32 %1, %2, %2, %1\n\tv_fma_f32 %0, %2, %2, %0\n\tv_fma_f32 %1, %2, %2, %1\n\t"
                   "v_fma_f32 %0, %2, %2, %0\n\tv_fma_f32 %1, %2, %2, %1\n\tv_fma_f32 %0, %2, %2, %0\n\tv_fma_f32 %1, %2, %2, %1\n\t"
                   "v_fma_f32 %0, %2, %2, %0\n\tv_fma_f32 %1, %2, %2, %1\n\tv_fma_f32 %0, %2, %2, %0\n\tv_fma_f32 %1, %2, %2, %1"
                   : "+v"(r0[0]), "+v"(r1[0]) : "v"(w[0]));
#elif FP6_PROBE == 5
      asm volatile("v_fma_f32 %0, %16, %16, %16\n\tv_fma_f32 %1, %16, %16, %16\n\tv_fma_f32 %2, %16, %16, %16\n\tv_fma_f32 %3, %16, %16, %16\n\tv_fma_f32 %4, %16, %16, %16\n\tv_fma_f32 %5, %16, %16, %16\n\tv_fma_f32 %6, %16, %16, %16\n\tv_fma_f32 %7, %16, %16, %16\n\tv_fma_f32 %8, %16, %16, %16\n\tv_fma_f32 %9, %16, %16, %16\n\tv_fma_f32 %10, %16, %16, %16\n\tv_fma_f32 %11, %16, %16, %16\n\tv_fma_f32 %12, %16, %16, %16\n\tv_fma_f32 %13, %16, %16, %16\n\tv_fma_f32 %14, %16, %16, %16\n\tv_fma_f32 %15, %16, %16, %16" : "=v"(r0[0]), "=v"(r0[1]), "=v"(r0[2]), "=v"(r0[3]), "=v"(r0[4]), "=v"(r0[5]), "=v"(r0[6]), "=v"(r0[7]), "=v"(r1[0]), "=v"(r1[1]), "=v"(r1[2]), "=v"(r1[3]), "=v"(r1[4]), "=v"(r1[5]), "=v"(r1[6]), "=v"(r1[7]) : "v"(w[0]));
#elif FP6_PROBE == 7
      asm volatile("s_sleep 16" ::: "memory");
#elif FP6_PROBE == 4
      asm volatile("v_pk_fma_f32 %0, %2, %2, %0\n\tv_pk_fma_f32 %1, %2, %2, %1\n\tv_pk_fma_f32 %0, %2, %2, %0\n\tv_pk_fma_f32 %1, %2, %2, %1\n\t"
                   "v_pk_fma_f32 %0, %2, %2, %0\n\tv_pk_fma_f32 %1, %2, %2, %1\n\tv_pk_fma_f32 %0, %2, %2, %0\n\tv_pk_fma_f32 %1, %2, %2, %1\n\t"
                   "v_pk_fma_f32 %0, %2, %2, %0\n\tv_pk_fma_f32 %1, %2, %2, %1\n\tv_pk_fma_f32 %0, %2, %2, %0\n\tv_pk_fma_f32 %1, %2, %2, %1\n\t"
                   "v_pk_fma_f32 %0, %2, %2, %0\n\tv_pk_fma_f32 %1, %2, %2, %1\n\tv_pk_fma_f32 %0, %2, %2, %0\n\tv_pk_fma_f32 %1, %2, %2, %1"
                   : "+v"(*(f32x2*)&r0), "+v"(*(f32x2*)&r1) : "v"(*(f32x2*)&w[0]));
#else
      asm volatile("v_cvt_pk_f32_fp8 %0, %2\n\tv_cvt_pk_f32_fp8 %1, %2 src0_sel:WORD_1\n\tv_cvt_pk_f32_fp8 %0, %2\n\tv_cvt_pk_f32_fp8 %1, %2 src0_sel:WORD_1\n\t"
                   "v_cvt_pk_f32_fp8 %0, %2\n\tv_cvt_pk_f32_fp8 %1, %2 src0_sel:WORD_1\n\tv_cvt_pk_f32_fp8 %0, %2\n\tv_cvt_pk_f32_fp8 %1, %2 src0_sel:WORD_1\n\t"
                   "v_cvt_pk_f32_fp8 %0, %2\n\tv_cvt_pk_f32_fp8 %1, %2 src0_sel:WORD_1\n\tv_cvt_pk_f32_fp8 %0, %2\n\tv_cvt_pk_f32_fp8 %1, %2 src0_sel:WORD_1\n\t"
                   "v_cvt_pk_f32_fp8 %0, %2\n\tv_cvt_pk_f32_fp8 %1, %2 src0_sel:WORD_1\n\tv_cvt_pk_f32_fp8 %0, %2\n\tv_cvt_pk_f32_fp8 %1, %2 src0_sel:WORD_1"
                   : "=v"(*(f32x2*)&r0), "=v"(*(f32x2*)&r1) : "v"(w[0]));
#endif
    }
    asm volatile("s_memtime %0\n\ts_waitcnt lgkmcnt(0)" : "=s"(t1) :: "memory");
    float sink = 0.f;
#if FP6_PROBE == 1
    sink = (r0[3] + r1[5] + r2[7] + r3[9]) * 0.f;
    const float cyc = (float)(t1 - t0) * (1.f / 1024.f);
#else
    sink = (r0[0] + r1[1]) * 0.f;
    const float cyc = (float)(t1 - t0) * (1.f / 256.f) * (FP6_PROBE == 7 ? 1.f / 16.f : 1.f);
#endif
    if (lane == 0) p.out[0] += (floorf(cyc + 0.5f) + sink) * (bad ? 1000.f : 1.f);
  }
#endif
#ifdef P6_STAMP
  xcd_barrier(xb);
  if (blockIdx.x == 0 && threadIdx.x == 0) {
    const unsigned long long* d = (const unsigned long long*)(p.ws + WS_END + 32768);
    p.out[0] += (float)((double)d[P6_STAMP] * 1e-5);
  }
#endif
#ifdef GS_STAMP
  xcd_barrier(xb);
  if (blockIdx.x == 0 && threadIdx.x == 0) {
    const unsigned long long* d = (const unsigned long long*)(p.ws + WS_END + 32768);
    p.out[0] += (float)((double)d[GS_STAMP_SEL] * 1e-3);
  }
#endif
}

extern "C" void kernel_launch(void* const* d_in, const int* in_sizes, int n_in, void* d_out, int out_size, void* d_ws,
                              size_t ws_size, hipStream_t stream) {
  static int grid = 0;
  if (grid == 0) {
    if (n_in != 18 || out_size != NTOK * 1024 || ws_size < WS_END + 65536) {
      fprintf(stderr, "kernel_launch: unexpected shapes (n_in %d out %d ws %zu need %llu)\n", n_in, out_size, ws_size, (unsigned long long)WS_END);
      grid = -1; return;
    }
    int dev = 0, cus = 0, per_cu = 0;
    hipGetDevice(&dev);
    hipDeviceGetAttribute(&cus, hipDeviceAttributeMultiprocessorCount, dev);
    hipFuncSetAttribute((const void*)mega_fwd, hipFuncAttributeMaxDynamicSharedMemorySize, LDS_ALLOC);
    hipOccupancyMaxActiveBlocksPerMultiprocessor(&per_cu, (const void*)mega_fwd, NTHREADS, LDS_ALLOC);
    if (per_cu < 1) { fprintf(stderr, "kernel_launch: occupancy query says %d blocks/CU\n", per_cu); grid = -1; return; }
    grid = cus;
    grid -= grid % 8;
    fprintf(stderr, "kernel_launch: grid %d (cus %d, per_cu %d)\n", grid, cus, per_cu);
  }
  if (grid < 0) return;
  Params p{};
  p.x = (const float*)d_in[0]; p.pos = (const int*)d_in[1]; p.attn_norm = (const float*)d_in[2]; p.w_in = (const float*)d_in[3];
  p.cq_norm = (const float*)d_in[4]; p.w_uq = (const float*)d_in[5]; p.ckv_norm = (const float*)d_in[6]; p.w_ukv = (const float*)d_in[7];
  p.q_norm = (const float*)d_in[8]; p.k_norm = (const float*)d_in[9]; p.sb_out_norm = (const float*)d_in[10];
  p.mla_out_norm = (const float*)d_in[11]; p.w_o = (const float*)d_in[12]; p.ffn_norm = (const float*)d_in[13];
  p.peer_wq = (const float*)d_in[14]; p.peer_sk = (const float*)d_in[15]; p.peer_u = (const float*)d_in[16]; p.peer_v = (const float*)d_in[17];
  p.out = (float*)d_out; p.ws = (char*)d_ws;
#if N_LAUNCH_SPLIT
  for (int ph = 0; ph < N_PHASES; ++ph) {
    p.ph_lo = ph; p.ph_hi = ph + 1;
    hipLaunchKernelGGL(mega_fwd, dim3(grid), dim3(NTHREADS), LDS_ALLOC, stream, p);
  }
#else
  p.ph_lo = 0; p.ph_hi = N_PHASES;
  void* args[] = {&p};
  hipError_t e = hipLaunchCooperativeKernel((const void*)mega_fwd, dim3(grid), dim3(NTHREADS), args, LDS_ALLOC, stream);
  if (e != hipSuccess) fprintf(stderr, "cooperative launch failed: %s (grid %d)\n", hipGetErrorString(e), grid);
#endif
}
```

```cpp
#include <hip/hip_runtime.h>
#include <hip/hip_cooperative_groups.h>
#include <cstdio>
namespace cg = cooperative_groups;

typedef unsigned short u16;
typedef unsigned int u32;
typedef short bf16x8 __attribute__((ext_vector_type(8)));
typedef float f32x16 __attribute__((ext_vector_type(16)));
typedef float f32x2 __attribute__((ext_vector_type(2)));
typedef __bf16 bf16x2_t __attribute__((ext_vector_type(2)));
#define DI __device__ __forceinline__

#define NTOK 65536
#define SEQ 4096
#define NB 16
#define DM 1024
#define INW 2208
#define INW_PAD 2304
#define NTHREADS 512

#define MB_ (1024ull * 1024ull)
#define WS_XB    (0ull)
#define WS_WINT  (128 * MB_)
#define WS_WUQT  (WS_WINT + 4718592ull)
#define WS_WUKVT (WS_WUQT + 589824ull)
#define WS_WOT   (WS_WUKVT + 524288ull)
#define WS_WPQT  (WS_WOT + 2097152ull)
#define WS_SUBK  (WS_WPQT + 4194304ull)
#define WS_UB    (WS_SUBK + 524288ull)
#define WS_VB    (WS_UB + 16 * MB_)
#define WS_RX    (WS_VB + 16 * MB_ + 131072ull)
#define WS_USC   (WS_VB + 16 * MB_)
#define WS_VSC   (WS_USC + 65536ull)
#define WS_R2    (WS_VB + 48 * MB_ + 1 * MB_)
#define WS_SBQ   (WS_R2)
#define WS_SBK   (WS_R2 + 64 * MB_)
#define WS_SBVT  (WS_R2 + 128 * MB_)
#define WS_IDX   (WS_R2)
#define WS_GATE  (WS_R2 + 32 * MB_)
#define WS_R3    (WS_R2 + 192 * MB_)
#define WS_CQ    (WS_R3)
#define WS_CKV   (WS_R3 + 48 * MB_)
#define WS_KPE   (WS_R3 + 80 * MB_)
#define WS_R4    (WS_R3 + 128 * MB_)
#define WS_MQ    (WS_R4)
#define WS_MK    (WS_R4 + 96 * MB_)
#define WS_MVT   (WS_R4 + 192 * MB_)
#define WS_SBO   (WS_R4 + 256 * MB_)
#define WS_MLAO  (WS_SBO + 64 * MB_)
#define WS_END   (WS_MLAO + 64 * MB_)

struct Params {
  const float* x; const int* pos; const float* attn_norm; const float* w_in; const float* cq_norm; const float* w_uq;
  const float* ckv_norm; const float* w_ukv; const float* q_norm; const float* k_norm; const float* sb_out_norm;
  const float* mla_out_norm; const float* w_o; const float* ffn_norm; const float* peer_wq; const float* peer_sk;
  const float* peer_u; const float* peer_v;
  float* out; char* ws;
  int ph_lo, ph_hi;
};

DI u32 pk_bf16(float a, float b) {
  f32x2 v = {a, b};
  bf16x2_t r = __builtin_convertvector(v, bf16x2_t);
  return __builtin_bit_cast(u32, r);
}
DI u16 f2bf(float a) { return (u16)(pk_bf16(a, 0.f) & 0xffffu); }
DI float bf_lo(u32 w) { return __uint_as_float(w << 16); }
DI float bf_hi(u32 w) { return __uint_as_float(w & 0xffff0000u); }
DI int crow(int reg, int h) { return (reg & 3) + 8 * (reg >> 2) + 4 * h; }
DI int swap23(int a) { return (a & ~12) | ((a >> 1) & 4) | ((a << 1) & 8); }
#define MFMA32(a, b, c) __builtin_amdgcn_mfma_f32_32x32x16_bf16((a), (b), (c), 0, 0, 0)
DI float shfl_xor_f(float v, int m) { return __shfl_xor(v, m, 64); }
DI int opaque_tid() { int t = threadIdx.x; asm volatile("" : "+v"(t)); return t; }
#ifndef XCD_CONSECUTIVE
#define XCD_CONSECUTIVE 0
#endif
#if XCD_CONSECUTIVE
#define VXCD ((int)(blockIdx.x / (gridDim.x >> 3)))
#define VCU  ((int)(blockIdx.x % (gridDim.x >> 3)))
#else
#define VXCD ((int)(blockIdx.x & 7))
#define VCU  ((int)(blockIdx.x >> 3))
#endif

template <typename ACC>
DI void store_block_bf16(u16* dst, const ACC& a, float sc, int lh) {
  u32 w[8];
#pragma unroll
  for (int g = 0; g < 4; ++g) { w[2 * g] = pk_bf16(a[4 * g] * sc, a[4 * g + 1] * sc); w[2 * g + 1] = pk_bf16(a[4 * g + 2] * sc, a[4 * g + 3] * sc); }
#pragma unroll
  for (int p2 = 0; p2 < 2; ++p2) {
    const auto r0 = __builtin_amdgcn_permlane32_swap(w[4 * p2], w[4 * p2 + 2], false, false);
    const auto r1 = __builtin_amdgcn_permlane32_swap(w[4 * p2 + 1], w[4 * p2 + 3], false, false);
    *(uint4*)(dst + 16 * p2 + 8 * lh) = make_uint4(r0[0], r1[0], r0[1], r1[1]);
  }
}
#ifndef GEMM_YOUNG_PRIO
#define GEMM_YOUNG_PRIO 1
#endif
typedef __attribute__((address_space(3))) unsigned lds_u32;
template <int N> DI void wait_vm() { asm volatile("s_waitcnt vmcnt(%0)" ::"n"(N) : "memory"); }
DI void block_barrier() { asm volatile("" ::: "memory"); __builtin_amdgcn_s_barrier(); asm volatile("" ::: "memory"); }
DI float dot2_self(u32 w, float c) {
  const bf16x2_t a = __builtin_bit_cast(bf16x2_t, w);
  return __builtin_amdgcn_fdot2_f32_bf16(a, a, c, false);
}

struct Seg { const u16* P; const u16* Q; int nk; };

template <int WP, int WQ, int PB, int QB, int NST, int SSQ>
struct GemmStream {
  static constexpr int TP = WP * PB * 32, TQ = WQ * QB * 32;
  static constexpr int NPP = TP / 64, NQP = TQ / 64, NPIECE = NPP + NQP;
  static constexpr int STAGE_BYTES = (TP + TQ) * 128;
  static constexpr int LDS_BYTES = NST * STAGE_BYTES;
  static constexpr int DEPTH = NST - 1;
  static constexpr int NSS = (SSQ == 1) ? QB : ((SSQ == 2) ? PB : 1);

  char* smem;
  int ldp, ldq;
  int st_issue, st_comp;
  int wave, wp, wq, l31, lh;
  unsigned p_off, q_off;
  unsigned lds_piece;
#ifdef GS_STAMP
  unsigned long long tacc[5];
  DI unsigned long long stamp() { unsigned long long t; asm volatile("s_memtime %0\n\ts_waitcnt lgkmcnt(0)" : "=s"(t) :: "memory"); return t; }
#endif

  DI void init(char* smem_, int ldp_, int ldq_) {
    smem = smem_; ldp = ldp_; ldq = ldq_;
    const int tid = opaque_tid(), lane = tid & 63;
    wave = __builtin_amdgcn_readfirstlane(tid >> 6); wp = wave / WQ; wq = wave % WQ; l31 = lane & 31; lh = lane >> 5;
    const int srow = 8 * wave + (lane >> 3);
    const int c = (lane & 7) ^ ((srow >> 1) & 7);
    p_off = (unsigned)(srow * ldp * 2 + c * 16);
    q_off = (unsigned)(srow * ldq * 2 + c * 16);
    lds_piece = (unsigned)(8 * wave * 128);
    st_issue = 0; st_comp = 0;
#ifdef GS_STAMP
    for (int i = 0; i < 5; ++i) tacc[i] = 0;
#endif
#if GEMM_YOUNG_PRIO
    if (wave >= 4) __builtin_amdgcn_s_setprio(1);
#endif
  }
  DI void issue_part(const Seg& s, int kt, int i0, int i1) {
    char* sb = smem + st_issue * STAGE_BYTES + lds_piece;
    const char* pg = (const char*)s.P + p_off + kt * 128;
    const char* qg = (const char*)s.Q + q_off + kt * 128;
#pragma unroll
    for (int i = 0; i < NPIECE; ++i) {
      if (i < i0 || i >= i1) continue;
      if (i < NPP) __builtin_amdgcn_global_load_lds((const unsigned*)(pg + (size_t)i * 64 * ldp * 2), (lds_u32*)(sb + i * 64 * 128), 16, 0, 0);
      else __builtin_amdgcn_global_load_lds((const unsigned*)(qg + (size_t)(i - NPP) * 64 * ldq * 2), (lds_u32*)(sb + TP * 128 + (i - NPP) * 64 * 128), 16, 0, 0);
    }
  }
  DI void issue_done() { st_issue = (st_issue + 1 == NST) ? 0 : st_issue + 1; }
  DI void issue(const Seg& s, int kt) { issue_part(s, kt, 0, NPIECE); issue_done(); }
  DI void load_frags(const char* sb, int ks, bf16x8 (&pf)[PB], bf16x8 (&qf)[QB]) {
#pragma unroll
    for (int pb = 0; pb < PB; ++pb) {
      const int r = wp * PB * 32 + pb * 32 + l31;
      pf[pb] = *(const bf16x8*)(sb + r * 128 + (((ks * 2 + lh) ^ ((r >> 1) & 7)) << 4));
    }
#pragma unroll
    for (int qb = 0; qb < QB; ++qb) {
      const int r = wq * QB * 32 + qb * 32 + l31;
      qf[qb] = *(const bf16x8*)(sb + TP * 128 + r * 128 + (((ks * 2 + lh) ^ ((r >> 1) & 7)) << 4));
    }
  }
  DI void compute(f32x16 (&acc)[PB][QB], float (&ss)[NSS], const Seg& is, int ikt) {
    const char* sb = smem + st_comp * STAGE_BYTES;
    if (DEPTH < 2) issue_part(is, ikt, 0, NPIECE);
#pragma unroll
    for (int ks = 0; ks < 4; ++ks) {
      bf16x8 pf[PB], qf[QB];
      load_frags(sb, ks, pf, qf);
#pragma unroll
      for (int pb = 0; pb < PB; ++pb)
#pragma unroll
        for (int qb = 0; qb < QB; ++qb) acc[pb][qb] = MFMA32(pf[pb], qf[qb], acc[pb][qb]);
      if (DEPTH >= 2) issue_part(is, ikt, (ks * NPIECE) / 4, ((ks + 1) * NPIECE) / 4);
      if (SSQ == 1) {
#pragma unroll
        for (int qb = 0; qb < QB; ++qb) {
          const uint4 w = __builtin_bit_cast(uint4, qf[qb]);
          ss[qb] = dot2_self(w.x, ss[qb]); ss[qb] = dot2_self(w.y, ss[qb]); ss[qb] = dot2_self(w.z, ss[qb]); ss[qb] = dot2_self(w.w, ss[qb]);
        }
      } else if (SSQ == 2) {
#pragma unroll
        for (int pb = 0; pb < PB; ++pb) {
          const uint4 w = __builtin_bit_cast(uint4, pf[pb]);
          ss[pb] = dot2_self(w.x, ss[pb]); ss[pb] = dot2_self(w.y, ss[pb]); ss[pb] = dot2_self(w.z, ss[pb]); ss[pb] = dot2_self(w.w, ss[pb]);
        }
      }
    }
    issue_done();
    st_comp = (st_comp + 1 == NST) ? 0 : st_comp + 1;
  }
  DI void prologue(const Seg& s) {
#pragma unroll
    for (int d = 0; d < DEPTH; ++d) issue(s, d);
  }
  DI void run(f32x16 (&acc)[PB][QB], float (&ss)[NSS], const Seg& cur, const Seg& nxt) {
#pragma unroll
    for (int i = 0; i < NSS; ++i) ss[i] = 0.f;
    const int nk = cur.nk;
#pragma unroll 1
    for (int kt = 0; kt < nk; ++kt) {
#ifdef GS_STAMP
      __builtin_amdgcn_sched_barrier(0); const unsigned long long t0 = stamp(); __builtin_amdgcn_sched_barrier(0);
#endif
      wait_vm<(DEPTH - 1) * NPIECE>();
#ifdef GS_STAMP
      __builtin_amdgcn_sched_barrier(0); const unsigned long long t1 = stamp(); __builtin_amdgcn_sched_barrier(0);
#endif
      block_barrier();
#ifdef GS_STAMP
      __builtin_amdgcn_sched_barrier(0); const unsigned long long t2 = stamp(); __builtin_amdgcn_sched_barrier(0);
#endif
      {
        const bool in_cur = kt + DEPTH < nk;
        Seg is; is.P = in_cur ? cur.P : nxt.P; is.Q = in_cur ? cur.Q : nxt.Q; is.nk = 0;
        compute(acc, ss, is, in_cur ? kt + DEPTH : kt + DEPTH - nk);
      }
#ifdef GS_STAMP
      __builtin_amdgcn_sched_barrier(0); const unsigned long long t4 = stamp(); __builtin_amdgcn_sched_barrier(0);
      tacc[0] += t1 - t0; tacc[1] += t2 - t1; tacc[3] += t4 - t2; tacc[4] += 1;
#endif
    }
#pragma unroll
    for (int i = 0; i < NSS; ++i) ss[i] += shfl_xor_f(ss[i], 32);
  }
  DI void drain() {
    wait_vm<0>();
    block_barrier();
    st_issue = 0; st_comp = 0;
#if GEMM_YOUNG_PRIO
    __builtin_amdgcn_s_setprio(0);
#endif
  }
};

template <int PB, int QB>
DI void zero_acc(f32x16 (&acc)[PB][QB]) {
#pragma unroll
  for (int a = 0; a < PB; ++a)
#pragma unroll
    for (int b = 0; b < QB; ++b)
#pragma unroll
      for (int r = 0; r < 16; ++r) acc[a][b][r] = 0.f;
}
DI void prep_transpose_tile(u16* __restrict__ dst, const float* __restrict__ src, const float* __restrict__ gain,
                            int N, int K, int tn, int tk, int n_scaled, float nscale, char* smem) {
  float* tile = (float*)smem;
  const int tid = opaque_tid();
  const int c = tid & 63, r0 = tid >> 6;
#pragma unroll
  for (int i = 0; i < 8; ++i) {
    const int kr = r0 + i * 8, k = tk * 64 + kr, n = tn * 64 + c;
    float v = 0.f;
    if (n < N) v = src[(size_t)k * N + n] * (gain ? gain[k] : 1.f);
    tile[kr * 65 + c] = v;
  }
  __syncthreads();
#pragma unroll
  for (int i = 0; i < 8; ++i) {
    const int nr = r0 + i * 8, n = tn * 64 + nr, k = tk * 64 + c;
    float v = tile[c * 65 + nr];
    if (n < n_scaled) v *= nscale;
    dst[(size_t)n * K + k] = f2bf(v);
  }
  __syncthreads();
}

DI u32 pack_i8(float a, float b, float c, float d) {
  const int ia = __float2int_rn(a), ib = __float2int_rn(b), ic = __float2int_rn(c), id = __float2int_rn(d);
  return ((u32)ia & 255u) | (((u32)ib & 255u) << 8) | (((u32)ic & 255u) << 16) | ((u32)id << 24);
}
DI u32 fp6_code(float q) {
  const u32 b = __float_as_uint(q);
  const u32 sg = (b >> 26) & 32u;
  const u32 ab = b & 0x7fffffffu;
  const float a = __uint_as_float(ab);
  const u32 rn = (ab + 0x7ffffu + ((ab >> 20) & 1u)) >> 20;
  u32 c = (a < 1.f) ? (u32)__float2int_rn(a * 8.f) : (rn - 1008u);
  c = c < 31u ? c : 31u;
  return sg | c;
}
DI void phase_prep(const Params& p, char* smem) {
  const int tid = opaque_tid();
  const size_t gtid = (size_t)blockIdx.x * NTHREADS + tid, gstride = (size_t)gridDim.x * NTHREADS;
  char* ws = p.ws;
  {
    const int n0 = 36 * 16, n1 = n0 + 12 * 6, n2 = n1 + 16 * 4, n3 = n2 + 16 * 16, n4 = n3 + 32 * 16;
    for (int w = blockIdx.x; w < n4; w += gridDim.x) {
      if (w < n0) {
        prep_transpose_tile((u16*)(ws + WS_WINT), p.w_in, p.attn_norm, INW, 1024, w / 16, w % 16, 512, 0.125f * 1.4426950408889634f, smem);
      } else if (w < n1) {
        const int v = w - n0; prep_transpose_tile((u16*)(ws + WS_WUQT), p.w_uq, p.cq_norm, 768, 384, v / 6, v % 6, 0, 1.f, smem);
      } else if (w < n2) {
        const int v = w - n1; prep_transpose_tile((u16*)(ws + WS_WUKVT), p.w_ukv, p.ckv_norm, 1024, 256, v / 4, v % 4, 0, 1.f, smem);
      } else if (w < n3) {
        const int v = w - n2; const int tk = v % 16;
        prep_transpose_tile((u16*)(ws + WS_WOT), p.w_o, (tk < 8) ? p.sb_out_norm : (p.mla_out_norm - 512), 1024, 1024, v / 16, tk, 0, 1.f, smem);
      } else {
        const int v = w - n3; prep_transpose_tile((u16*)(ws + WS_WPQT), p.peer_wq, p.ffn_norm, 2048, 1024, v / 16, v % 16, 0, 1.f, smem);
      }
    }
  }
  if (blockIdx.x == 0 && tid < 8) ((unsigned*)(ws + WS_END + 49152))[64 * tid] = 0u;
  {
    u16* dst = (u16*)(ws + WS_SUBK);
    for (size_t i = gtid; i < 2ull * 8 * 128 * 128; i += gstride) {
      const int pp = (int)(i & 127);
      const int d = (pp & ~15) | swap23(pp & 15);
      dst[i] = f2bf(p.peer_sk[(i & ~127ull) | d]);
    }
  }
  {
    const int lane = tid & 63;
    const int gw = blockIdx.x * 8 + (tid >> 6), nw = gridDim.x * 8;
    float* rx = (float*)(ws + WS_RX);
    for (int row0 = gw * 4; row0 < NTOK; row0 += nw * 4) {
      float4 a[4][4];
#pragma unroll
      for (int r = 0; r < 4; ++r)
#pragma unroll
        for (int i = 0; i < 4; ++i) a[r][i] = ((const float4*)(p.x + (size_t)(row0 + r) * 1024))[lane + 64 * i];
#pragma unroll
      for (int r = 0; r < 4; ++r) {
        uint2* dst = (uint2*)(ws + WS_XB + (size_t)(row0 + r) * 2048);
        float ss = 0.f;
#pragma unroll
        for (int i = 0; i < 4; ++i) {
          const float4 v = a[r][i];
          ss += v.x * v.x + v.y * v.y + v.z * v.z + v.w * v.w;
          dst[lane + 64 * i] = make_uint2(pk_bf16(v.x, v.y), pk_bf16(v.z, v.w));
        }
        ss += shfl_xor_f(ss, 32); ss += shfl_xor_f(ss, 16); ss += shfl_xor_f(ss, 8); ss += shfl_xor_f(ss, 4); ss += shfl_xor_f(ss, 2); ss += shfl_xor_f(ss, 1);
        if (lane == 0) rx[row0 + r] = rsqrtf(ss * (1.f / 1024.f) + 1e-6f);
      }
    }
  }
  {
    const int lane = tid & 63;
    const int gw = blockIdx.x * 8 + (tid >> 6), nw = gridDim.x * 8;
    const float4* g4 = (const float4*)p.ffn_norm;
    for (int row0 = gw * 4; row0 < 2 * 16384; row0 += nw * 4) {
      const bool isv = row0 >= 16384;
      const int e0 = row0 & 16383;
      float4 v[4][4];
#pragma unroll
      for (int r = 0; r < 4; ++r)
#pragma unroll
        for (int i = 0; i < 4; ++i) v[r][i] = ((const float4*)((isv ? p.peer_v : p.peer_u) + (size_t)(e0 + r) * 1024))[lane + 64 * i];
      float4 g[4];
#pragma unroll
      for (int i = 0; i < 4; ++i) g[i] = isv ? make_float4(1.f, 1.f, 1.f, 1.f) : g4[lane + 64 * i];
#pragma unroll
      for (int r = 0; r < 4; ++r) {
        float m = 0.f;
#pragma unroll
        for (int i = 0; i < 4; ++i) {
          v[r][i].x *= g[i].x; v[r][i].y *= g[i].y; v[r][i].z *= g[i].z; v[r][i].w *= g[i].w;
          m = fmaxf(m, fmaxf(fmaxf(fabsf(v[r][i].x), fabsf(v[r][i].y)), fmaxf(fabsf(v[r][i].z), fabsf(v[r][i].w))));
        }
        m = fmaxf(m, shfl_xor_f(m, 32)); m = fmaxf(m, shfl_xor_f(m, 16)); m = fmaxf(m, shfl_xor_f(m, 8));
        m = fmaxf(m, shfl_xor_f(m, 4)); m = fmaxf(m, shfl_xor_f(m, 2)); m = fmaxf(m, shfl_xor_f(m, 1));
        if (isv) {
          const float sc = (m > 0.f) ? 7.5f / m : 1.f;
          u32 c[16];
#pragma unroll
          for (int i = 0; i < 4; ++i) {
            c[4 * i] = fp6_code(v[r][i].x * sc); c[4 * i + 1] = fp6_code(v[r][i].y * sc);
            c[4 * i + 2] = fp6_code(v[r][i].z * sc); c[4 * i + 3] = fp6_code(v[r][i].w * sc);
          }
          const u32 w0 = c[0] | (c[1] << 6) | (c[2] << 12) | (c[3] << 18) | (c[4] << 24) | (c[5] << 30);
          const u32 w1 = (c[5] >> 2) | (c[6] << 4) | (c[7] << 10) | (c[8] << 16) | (c[9] << 22) | (c[10] << 28);
          const u32 w2 = (c[10] >> 4) | (c[11] << 2) | (c[12] << 8) | (c[13] << 14) | (c[14] << 20) | (c[15] << 26);
          u32* dst = (u32*)(ws + WS_VB + (size_t)(e0 + r) * 768) + 3 * lane;
          *(uint3*)dst = make_uint3(w0, w1, w2);
          if (lane == 0) ((float*)(ws + WS_VSC))[e0 + r] = (m > 0.f) ? m * (1.f / 7.5f) : 1.f;
        } else {
          const float sc = (m > 0.f) ? 127.f / m : 1.f;
          u32 wq[4];
#pragma unroll
          for (int i = 0; i < 4; ++i) wq[i] = pack_i8(v[r][i].x * sc, v[r][i].y * sc, v[r][i].z * sc, v[r][i].w * sc);
          *(uint4*)(ws + WS_UB + (size_t)(e0 + r) * 1024 + 16 * lane) = make_uint4(wq[0], wq[1], wq[2], wq[3]);
          if (lane == 0) ((float*)(ws + WS_USC))[e0 + r] = (m > 0.f) ? m * (1.f / 127.f) : 1.f;
        }
      }
    }
  }
}

typedef GemmStream<2, 4, 2, 2, 3, 0> G1;
DI void phase_inproj(const Params& p, char* smem) {
  char* ws = p.ws;
  const int tid = opaque_tid(), lane = tid & 63, wave = tid >> 6;
  const int wp = wave / 4, wq = wave % 4, l31 = lane & 31, lh = lane >> 5;
  const int xcd = VXCD, cu = VCU, ncu = gridDim.x >> 3;
  G1 gs; gs.init(smem, 1024, 1024);
#ifdef GS_STAMP
  const unsigned long long ph_c0 = __builtin_amdgcn_s_memtime(), ph_r0 = __builtin_amdgcn_s_memrealtime();
#endif
  auto tile_nt = [&](int w) { return (w % 144) / 8; };
  auto tile_tt = [&](int w) { return ((w / 144) * 8 + (w % 8)) * 8 + xcd; };
  auto seg = [&](int w) { Seg s; s.P = (const u16*)(ws + WS_WINT) + (size_t)tile_nt(w) * 128 * 1024; s.Q = (const u16*)(ws + WS_XB) + (size_t)tile_tt(w) * 256 * 1024; s.nk = 16; return s; };
  Seg cur = seg(cu);
  gs.prologue(cur);
  for (int w = cu; w < 32 * 18; w += ncu) {
    const int tt = tile_tt(w), nt = tile_nt(w);
    const Seg nxt = (w + ncu < 32 * 18) ? seg(w + ncu) : cur;
    f32x16 acc[2][2];
    float ssq[1];
    zero_acc(acc);
    gs.run(acc, ssq, cur, nxt);
    cur = nxt;
#pragma unroll
    for (int qb = 0; qb < 2; ++qb) {
      const int tl = wq * 64 + qb * 32 + l31;
      const int t = tt * 256 + tl;
      const float rt = ((const float*)(ws + WS_RX))[t];
#pragma unroll
      for (int pb = 0; pb < 2; ++pb) {
        const int nb = nt * 128 + wp * 64 + pb * 32;
        if (nb >= INW) continue;
        if (nb < 1024) {
          u16* dst = (u16*)(ws + (nb < 512 ? WS_SBQ : WS_SBK)) + (size_t)t * 512 + (nb & 511);
          store_block_bf16(dst, acc[pb][qb], rt, lh);
        } else if (nb < 1536) {
          const int hd = (nb - 1024);
          const int b = t >> 12, s = t & 4095;
          const int sp = (s & ~15) | swap23(s & 15);
          u16* dst = (u16*)(ws + WS_SBVT) + ((size_t)b * 512 + hd) * 4096 + sp;
#pragma unroll
          for (int r = 0; r < 16; ++r) dst[(size_t)crow(r, lh) * 4096] = f2bf(acc[pb][qb][r] * rt);
        } else if (nb < 1920) {
          u16* dst = (u16*)(ws + WS_CQ) + (size_t)t * 384 + (nb - 1536);
          store_block_bf16(dst, acc[pb][qb], rt, lh);
        } else if (nb < 2176) {
          u16* dst = (u16*)(ws + WS_CKV) + (size_t)t * 256 + (nb - 1920);
          store_block_bf16(dst, acc[pb][qb], rt, lh);
        } else {
          float* dst = (float*)(ws + WS_KPE) + (size_t)t * 32;
#pragma unroll
          for (int g = 0; g < 4; ++g) {
            const f32x16& a = acc[pb][qb];
            *(float4*)(dst + 8 * g + 4 * lh) = make_float4(a[4 * g] * rt, a[4 * g + 1] * rt, a[4 * g + 2] * rt, a[4 * g + 3] * rt);
          }
        }
      }
    }
  }
  gs.drain();
#ifdef GS_STAMP
  if (blockIdx.x == GS_STAMP_BLK && (threadIdx.x >> 6) == GS_STAMP_WAVE && (threadIdx.x & 63) == 0) {
    unsigned long long* d = (unsigned long long*)(ws + WS_END + 32768);
    for (int i = 0; i < 5; ++i) d[i] = gs.tacc[i];
    d[5] = __builtin_amdgcn_s_memtime() - ph_c0; d[6] = (__builtin_amdgcn_s_memrealtime() - ph_r0) * 10;
  }
#endif
}
DI float rope_invf(int i0, int lh) {
  constexpr float C[16] = {1.0f, 0.5623413251903491f, 0.31622776601683794f, 0.17782794100389228f, 0.1f, 0.05623413251903491f,
                           0.03162277660168379f, 0.01778279410038923f, 0.01f, 0.005623413251903491f, 0.0031622776601683794f,
                           0.0017782794100389228f, 0.001f, 0.0005623413251903491f, 0.00031622776601683794f, 0.00017782794100389228f};
  return lh ? C[i0 + 4] : C[i0];
}
DI void sincos_turns(float ang, float& s, float& c) {
  float tr = ang * 0.15915494309189535f;
  tr = tr - floorf(tr);
  s = __builtin_amdgcn_sinf(tr);
  c = __builtin_amdgcn_cosf(tr);
}

typedef GemmStream<2, 4, 3, 1, 3, 1> G2Q;
typedef GemmStream<2, 4, 4, 1, 3, 1> G2KV;

DI void mla_q_tile(const Params& p, G2Q& gs, const Seg& cur, const Seg& nxt, int tt, int nt) {
  char* ws = p.ws;
  const int tid = opaque_tid(), lane = tid & 63, wave = tid >> 6;
  const int wp = wave / 4, wq = wave % 4, l31 = lane & 31, lh = lane >> 5;
  float ssq[1];
  f32x16 acc[3][1];
  zero_acc(acc);
  gs.run(acc, ssq, cur, nxt);
  const int hd = nt * 2 + wp;
  const float qscale = 0.10206207261596577f * 1.4426950408889634f;
#pragma unroll
  for (int qb = 0; qb < 1; ++qb) {
    const int tl = wq * 32 + l31;
    const int t = tt * 128 + tl;
    const float rc = rsqrtf(ssq[0] * (1.f / 384.f) + 1e-6f);
    float ss = 0.f;
#pragma unroll
    for (int pb = 0; pb < 3; ++pb)
#pragma unroll
      for (int r = 0; r < 16; ++r) { const float v = acc[pb][qb][r] * rc; acc[pb][qb][r] = v; ss += v * v; }
    ss += shfl_xor_f(ss, 32);
    const float rq = rsqrtf(ss * (1.f / 96.f) + 1e-6f) ;
#pragma unroll
    for (int pb = 0; pb < 3; ++pb)
#pragma unroll
      for (int g = 0; g < 4; ++g) {
        const float4 gn = *(const float4*)(p.q_norm + pb * 32 + 8 * g + 4 * lh);
        acc[pb][qb][4 * g] *= rq * gn.x; acc[pb][qb][4 * g + 1] *= rq * gn.y; acc[pb][qb][4 * g + 2] *= rq * gn.z; acc[pb][qb][4 * g + 3] *= rq * gn.w;
      }
    const float posf = (float)p.pos[t];
#pragma unroll
    for (int r = 0; r < 8; ++r) {
      const int i0 = (r & 3) + 8 * (r >> 2);
      float s, c; sincos_turns(posf * rope_invf(i0, lh), s, c);
      const float x1 = acc[2][qb][r], x2 = acc[2][qb][r + 8];
      acc[2][qb][r] = x1 * c - x2 * s;
      acc[2][qb][r + 8] = x1 * s + x2 * c;
    }
    const int b = t >> 12, sidx = t & 4095;
    u16* dst = (u16*)(ws + WS_MQ) + ((size_t)(b * 8 + hd) * 4096 + sidx) * 96;
#pragma unroll
    for (int pb = 0; pb < 3; ++pb) store_block_bf16(dst + pb * 32, acc[pb][qb], qscale, lh);
  }
}

DI void mla_kv_tile(const Params& p, G2KV& gs, const Seg& cur, const Seg& nxt, int tt, int nt) {
  char* ws = p.ws;
  const int tid = opaque_tid(), lane = tid & 63, wave = tid >> 6;
  const int wp = wave / 4, wq = wave % 4, l31 = lane & 31, lh = lane >> 5;
  float ssq[1];
  f32x16 acc[4][1];
  zero_acc(acc);
  gs.run(acc, ssq, cur, nxt);
  const int hd = nt * 2 + wp;
#pragma unroll
  for (int qb = 0; qb < 1; ++qb) {
    const int tl = wq * 32 + l31;
    const int t = tt * 128 + tl;
    const float rkv = rsqrtf(ssq[0] * (1.f / 256.f) + 1e-6f);
    float kp[16];
    const float* kpe = (const float*)(ws + WS_KPE) + (size_t)t * 32;
#pragma unroll
    for (int g = 0; g < 4; ++g) {
      const float4 v = *(const float4*)(kpe + 8 * g + 4 * lh);
      kp[4 * g] = v.x; kp[4 * g + 1] = v.y; kp[4 * g + 2] = v.z; kp[4 * g + 3] = v.w;
    }
    float ss = 0.f;
#pragma unroll
    for (int pb = 0; pb < 2; ++pb)
#pragma unroll
      for (int r = 0; r < 16; ++r) { const float v = acc[pb][qb][r] * rkv; acc[pb][qb][r] = v; ss += v * v; }
#pragma unroll
    for (int r = 0; r < 16; ++r) ss += kp[r] * kp[r];
    ss += shfl_xor_f(ss, 32);
    const float rk = rsqrtf(ss * (1.f / 96.f) + 1e-6f);
#pragma unroll
    for (int pb = 0; pb < 2; ++pb)
#pragma unroll
      for (int g = 0; g < 4; ++g) {
        const float4 gn = *(const float4*)(p.k_norm + pb * 32 + 8 * g + 4 * lh);
        acc[pb][qb][4 * g] *= rk * gn.x; acc[pb][qb][4 * g + 1] *= rk * gn.y; acc[pb][qb][4 * g + 2] *= rk * gn.z; acc[pb][qb][4 * g + 3] *= rk * gn.w;
      }
#pragma unroll
    for (int g = 0; g < 4; ++g) {
      const float4 gn = *(const float4*)(p.k_norm + 64 + 8 * g + 4 * lh);
      kp[4 * g] *= rk * gn.x; kp[4 * g + 1] *= rk * gn.y; kp[4 * g + 2] *= rk * gn.z; kp[4 * g + 3] *= rk * gn.w;
    }
    const float posf = (float)p.pos[t];
#pragma unroll
    for (int r = 0; r < 8; ++r) {
      const int i0 = (r & 3) + 8 * (r >> 2);
      float s, c; sincos_turns(posf * rope_invf(i0, lh), s, c);
      const float x1 = kp[r], x2 = kp[r + 8];
      kp[r] = x1 * c - x2 * s;
      kp[r + 8] = x1 * s + x2 * c;
    }
    const int b = t >> 12, sidx = t & 4095;
    u16* dst = (u16*)(ws + WS_MK) + ((size_t)(b * 8 + hd) * 4096 + sidx) * 96;
#pragma unroll
    for (int pb = 0; pb < 2; ++pb) store_block_bf16(dst + pb * 32, acc[pb][qb], 1.f, lh);
    store_block_bf16(dst + 64, kp, 1.f, lh);
    const int sp = (sidx & ~15) | swap23(sidx & 15);
    u16* dv = (u16*)(ws + WS_MVT) + ((size_t)(b * 8 + hd) * 64) * 4096 + sp;
#pragma unroll
    for (int pb = 2; pb < 4; ++pb)
#pragma unroll
      for (int r = 0; r < 16; ++r) dv[(size_t)((pb - 2) * 32 + crow(r, lh)) * 4096] = f2bf(acc[pb][qb][r] * rkv);
  }
}

DI void phase_mlaproj(const Params& p, char* smem) {
  char* ws = p.ws;
  const int xcd = VXCD, cu = VCU, ncu = gridDim.x >> 3;
  {
    G2Q gs; gs.init(smem, 384, 384);
    auto seg = [&](int w) { Seg s; s.P = (const u16*)(ws + WS_WUQT) + (size_t)(w % 4) * 192 * 384; s.Q = (const u16*)(ws + WS_CQ) + (size_t)((w / 4) * 8 + xcd) * 128 * 384; s.nk = 6; return s; };
    Seg cur = seg(cu);
    gs.prologue(cur);
    for (int w = cu; w < 64 * 4; w += ncu) {
      const Seg nxt = (w + ncu < 64 * 4) ? seg(w + ncu) : cur;
      mla_q_tile(p, gs, cur, nxt, (w / 4) * 8 + xcd, w % 4);
      cur = nxt;
    }
    gs.drain();
  }
  {
    G2KV gs; gs.init(smem, 256, 256);
    auto seg = [&](int w) { Seg s; s.P = (const u16*)(ws + WS_WUKVT) + (size_t)(w % 4) * 256 * 256; s.Q = (const u16*)(ws + WS_CKV) + (size_t)((w / 4) * 8 + xcd) * 128 * 256; s.nk = 4; return s; };
    Seg cur = seg(cu);
    gs.prologue(cur);
    for (int w = cu; w < 64 * 4; w += ncu) {
      const Seg nxt = (w + ncu < 64 * 4) ? seg(w + ncu) : cur;
      mla_kv_tile(p, gs, cur, nxt, (w / 4) * 8 + xcd, w % 4);
      cur = nxt;
    }
    gs.drain();
  }
}
#define MLA_KROW 208
#define MLA_KBUF (64 * MLA_KROW)
#define MLA_VBUF (64 * 128)
#define MLA_KB2 12288
#define MLA_QOFF (2 * MLA_KB2 + 2 * MLA_VBUF)
DI void mla_attn_block512(const Params& p, char* smem, int b, int hd, int qblk, float Mb) {
  char* ws = p.ws;
  const int tid = opaque_tid(), lane = tid & 63, wave = __builtin_amdgcn_readfirstlane(tid >> 6), l31 = lane & 31, lh = lane >> 5;
  const int q0 = qblk * 512;
  const int nkt = q0 / 64 + 8;
  const int my_nkt = q0 / 64 + wave + 1;
  const char* Kg = (const char*)((const u16*)(ws + WS_MK) + (size_t)(b * 8 + hd) * 4096 * 96);
  const char* Vg = (const char*)((const u16*)(ws + WS_MVT) + (size_t)(b * 8 + hd) * 64 * 4096);
  char* Qs = smem + MLA_QOFF + wave * 64 * MLA_KROW;
  {
    const u16* Qg = (const u16*)(ws + WS_MQ) + ((size_t)(b * 8 + hd) * 4096 + q0 + wave * 64 + lane) * 96;
#pragma unroll 4
    for (int c = 0; c < 12; ++c) *(uint4*)(Qs + lane * MLA_KROW + c * 16) = *(const uint4*)(Qg + 8 * c);
  }
  f32x16 o[2][2];
#pragma unroll
  for (int g = 0; g < 2; ++g)
#pragma unroll
    for (int d = 0; d < 2; ++d)
#pragma unroll
      for (int r = 0; r < 16; ++r) o[g][d][r] = 0.f;
  float lsum0 = 0.f, lsum1 = 0.f;

  char* Kb = smem;
  char* Vb = smem + 2 * MLA_KB2;
  unsigned ksrc0, ksrc1, vsrc;
  {
    const int o0 = wave * 1024 + lane * 16, r0 = o0 / 192, c0 = (o0 % 192) >> 4;
    ksrc0 = (unsigned)(r0 * 192 + ((c0 & ~3) | ((c0 & 3) ^ ((r0 >> 2) & 3))) * 16);
    const int o1 = (8 + (wave & 3)) * 1024 + lane * 16, r1 = o1 / 192, c1 = (o1 % 192) >> 4;
    ksrc1 = (unsigned)(r1 * 192 + ((c1 & ~3) | ((c1 & 3) ^ ((r1 >> 2) & 3))) * 16);
    const int vr = wave * 8 + (lane >> 3), vc = (lane & 7) ^ ((vr >> 1) & 7);
    vsrc = (unsigned)(vr * 8192 + vc * 16);
  }
  auto issue = [&](int kt, int buf) {
    const char* kg = Kg + (size_t)kt * 64 * 192;
    __builtin_amdgcn_global_load_lds((const unsigned*)(kg + ksrc0), (lds_u32*)(Kb + buf * MLA_KB2 + wave * 1024), 16, 0, 0);
    if (wave < 4) __builtin_amdgcn_global_load_lds((const unsigned*)(kg + ksrc1), (lds_u32*)(Kb + buf * MLA_KB2 + (8 + wave) * 1024), 16, 0, 0);
    __builtin_amdgcn_global_load_lds((const unsigned*)(Vg + (size_t)kt * 128 + vsrc), (lds_u32*)(Vb + buf * MLA_VBUF + wave * 1024), 16, 0, 0);
  };
  auto qk = [&](f32x16 (&st)[2], const char* Qr, const char* Ks, float mb) {
#pragma unroll
    for (int kb = 0; kb < 2; ++kb)
#pragma unroll
      for (int r = 0; r < 16; ++r) st[kb][r] = -mb;
#pragma unroll
    for (int s = 0; s < 6; ++s) {
      const bf16x8 q = *(const bf16x8*)(Qr + l31 * MLA_KROW + (2 * s + lh) * 16);
#pragma unroll
      for (int kb = 0; kb < 2; ++kb) {
        const int r = kb * 32 + l31, c = 2 * s + lh;
        const bf16x8 kf = *(const bf16x8*)(Ks + r * 192 + (((c & ~3) | ((c & 3) ^ ((r >> 2) & 3))) << 4));
        st[kb] = MFMA32(kf, q, st[kb]);
      }
    }
  };
  auto softmax = [&](const f32x16 (&st)[2], bf16x8 (&pf)[4], float& lsum) {
#pragma unroll
    for (int kb = 0; kb < 2; ++kb) {
      float e[16];
#pragma unroll
      for (int r = 0; r < 16; ++r) { e[r] = __builtin_amdgcn_exp2f(st[kb][r]); lsum += e[r]; }
#pragma unroll
      for (int s2 = 0; s2 < 2; ++s2) {
        uint4 w = make_uint4(pk_bf16(e[8 * s2], e[8 * s2 + 1]), pk_bf16(e[8 * s2 + 2], e[8 * s2 + 3]),
                             pk_bf16(e[8 * s2 + 4], e[8 * s2 + 5]), pk_bf16(e[8 * s2 + 6], e[8 * s2 + 7]));
        pf[kb * 2 + s2] = __builtin_bit_cast(bf16x8, w);
      }
    }
  };
  auto pv = [&](f32x16 (&oo)[2], const bf16x8 (&pf)[4], const char* Vs) {
#pragma unroll
    for (int ks = 0; ks < 4; ++ks)
#pragma unroll
      for (int db = 0; db < 2; ++db) {
        const int r = db * 32 + l31;
        const bf16x8 vf = *(const bf16x8*)(Vs + r * 128 + (((2 * ks + lh) ^ ((r >> 1) & 7)) << 4));
        oo[db] = MFMA32(vf, pf[ks], oo[db]);
      }
  };
  issue(0, 0);
  wait_vm<0>();
  block_barrier();
#pragma unroll 1
  for (int t = 0; t < nkt; ++t) {
    if (t + 1 < nkt) issue(t + 1, (t + 1) & 1);
    if (t < my_nkt) {
      const char* Ks = Kb + (t & 1) * MLA_KB2;
      const char* Vs = Vb + (t & 1) * MLA_VBUF;
      float mb = Mb;
      asm volatile("" : "+v"(mb));
      f32x16 sa[2], sb[2];
      bf16x8 pfa[4], pfb[4];
      qk(sa, Qs, Ks, mb);
      qk(sb, Qs + 32 * MLA_KROW, Ks, mb);
      softmax(sa, pfa, lsum0);
      pv(o[0], pfa, Vs);
      softmax(sb, pfb, lsum1);
      pv(o[1], pfb, Vs);
    }
    wait_vm<0>();
    block_barrier();
  }
#pragma unroll
  for (int g = 0; g < 2; ++g) {
    float lsum = g ? lsum1 : lsum0;
    lsum += shfl_xor_f(lsum, 32);
    const float inv = 1.f / lsum;
    const int tq = b * 4096 + q0 + wave * 64 + g * 32 + l31;
    u16* dst = (u16*)(ws + WS_MLAO) + (size_t)tq * 512 + hd * 64;
#pragma unroll
    for (int db = 0; db < 2; ++db)
#pragma unroll
      for (int gg = 0; gg < 4; ++gg) {
        const f32x16& a = o[g][db];
        *(uint2*)(dst + db * 32 + 8 * gg + 4 * lh) = make_uint2(pk_bf16(a[4 * gg] * inv, a[4 * gg + 1] * inv), pk_bf16(a[4 * gg + 2] * inv, a[4 * gg + 3] * inv));
      }
  }
}

#define SBW_BACK 192
#define SBW_KOFF 0
#define SBW_VOFF 57344
#define SBW_VPITCH 912
DI void sb_attn_block256(const Params& p, char* smem, int b, int hd, int R0) {
  char* ws = p.ws;
  asm volatile("" : "+s"(ws));
  const int tid = opaque_tid(), lane = tid & 63, wave = __builtin_amdgcn_readfirstlane(tid >> 6), l31 = lane & 31, lh = lane >> 5;
  const int wlo = (R0 >= SBW_BACK) ? R0 - SBW_BACK : 0;
  const int nkeys = R0 + 256 - wlo;
  {
    const char* Kgw = (const char*)((const u16*)(ws + WS_SBK) + ((size_t)(b * 4096 + wlo)) * 512 + hd * 64);
    const char* Vgw = (const char*)((const u16*)(ws + WS_SBVT) + ((size_t)(b * 8 + hd) * 64) * 4096 + wlo);
    uint4 kk[7], vv[7];
#pragma unroll
    for (int j = 0; j < 7; ++j) {
      const int c = tid + 512 * j, row = c >> 3, ch = c & 7;
      kk[j] = (row < nkeys) ? *(const uint4*)(Kgw + (size_t)row * 1024 + ch * 16) : make_uint4(0, 0, 0, 0);
      const int dv = c / 56, vc = c - dv * 56;
      vv[j] = (vc * 8 < nkeys) ? *(const uint4*)(Vgw + (size_t)dv * 8192 + vc * 16) : make_uint4(0, 0, 0, 0);
    }
#pragma unroll
    for (int j = 0; j < 7; ++j) {
      const int c = tid + 512 * j, row = c >> 3, ch = c & 7;
      *(uint4*)(smem + SBW_KOFF + row * 128 + ((ch ^ ((row >> 1) & 7)) << 4)) = kk[j];
      const int dv = c / 56, vc = c - dv * 56;
      *(uint4*)(smem + SBW_VOFF + dv * SBW_VPITCH + vc * 16) = vv[j];
    }
  }
  __syncthreads();
  const int r0 = R0 + 32 * wave;
  const u16* Qg = (const u16*)(ws + WS_SBQ) + ((size_t)(b * 4096 + r0 + l31)) * 512 + hd * 64 + 8 * lh;
  const u16* Kg = (const u16*)(ws + WS_SBK) + ((size_t)(b * 4096 + l31)) * 512 + hd * 64 + 8 * lh;
  const u16* Vg = (const u16*)(ws + WS_SBVT) + ((size_t)(b * 8 + hd) * 64 + l31) * 4096 + 8 * lh;
  bf16x8 qf[4];
#pragma unroll
  for (int s = 0; s < 4; ++s) qf[s] = *(const bf16x8*)(Qg + 16 * s);
  f32x16 o[2];
#pragma unroll
  for (int d = 0; d < 2; ++d)
#pragma unroll
    for (int r = 0; r < 16; ++r) o[d][r] = 0.f;
  float carry = 0.f;
  auto tile = [&](const bf16x8 (&kf)[4], const bf16x8 (&vf)[2][2], bool diag) -> bool {
    f32x16 z;
#pragma unroll
    for (int r = 0; r < 16; ++r) z[r] = 0.f;
#pragma unroll
    for (int s = 0; s < 4; ++s) z = MFMA32(kf[s], qf[s], z);
    float lf[16], ls[16];
#pragma unroll
    for (int r = 0; r < 16; ++r) {
      const float zz = z[r];
      const float tt = __builtin_amdgcn_logf(1.f + __builtin_amdgcn_exp2f(-fabsf(zz)));
      lf[r] = -fmaxf(zz, 0.f) - tt;
      ls[r] = fminf(zz, 0.f) - tt;
      const bool masked = diag && !(crow(r, lh) < l31);
      if (masked) { lf[r] = 0.f; ls[r] = -INFINITY; }
    }
    float gs[4], pg[4];
#pragma unroll
    for (int g = 0; g < 4; ++g) { gs[g] = (lf[4 * g] + lf[4 * g + 1]) + (lf[4 * g + 2] + lf[4 * g + 3]); pg[g] = shfl_xor_f(gs[g], 32); }
    float so[4], spi[4];
    so[3] = 0.f; so[2] = gs[3]; so[1] = gs[3] + gs[2]; so[0] = so[1] + gs[1];
    spi[3] = pg[3]; spi[2] = pg[3] + pg[2]; spi[1] = spi[2] + pg[1]; spi[0] = spi[1] + pg[0];
    f32x16 a;
#pragma unroll
    for (int g = 0; g < 4; ++g) {
      const float spx = (g < 3) ? spi[g + 1] : 0.f;
      float base = carry + so[g] + (lh ? spx : spi[g]);
      a[4 * g + 3] = __builtin_amdgcn_exp2f(ls[4 * g + 3] + base); base += lf[4 * g + 3];
      a[4 * g + 2] = __builtin_amdgcn_exp2f(ls[4 * g + 2] + base); base += lf[4 * g + 2];
      a[4 * g + 1] = __builtin_amdgcn_exp2f(ls[4 * g + 1] + base); base += lf[4 * g + 1];
      a[4 * g + 0] = __builtin_amdgcn_exp2f(ls[4 * g + 0] + base);
    }
    carry += so[0] + gs[0] + spi[0];
#pragma unroll
    for (int s2 = 0; s2 < 2; ++s2) {
      uint4 w = make_uint4(pk_bf16(a[8 * s2], a[8 * s2 + 1]), pk_bf16(a[8 * s2 + 2], a[8 * s2 + 3]),
                           pk_bf16(a[8 * s2 + 4], a[8 * s2 + 5]), pk_bf16(a[8 * s2 + 6], a[8 * s2 + 7]));
      const bf16x8 pf = __builtin_bit_cast(bf16x8, w);
#pragma unroll
      for (int db = 0; db < 2; ++db) o[db] = MFMA32(vf[db][s2], pf, o[db]);
    }
    return __all(carry <= -151.f);
  };
  bool done = false;
#pragma unroll 1
  for (int k0 = r0; k0 >= wlo; k0 -= 32) {
    const int kr = k0 - wlo;
    bf16x8 kf[4], vf[2][2];
#pragma unroll
    for (int s = 0; s < 4; ++s) {
      const int r = kr + l31;
      kf[s] = *(const bf16x8*)(smem + SBW_KOFF + r * 128 + (((2 * s + lh) ^ ((r >> 1) & 7)) << 4));
    }
#pragma unroll
    for (int db = 0; db < 2; ++db)
#pragma unroll
      for (int s2 = 0; s2 < 2; ++s2) vf[db][s2] = *(const bf16x8*)(smem + SBW_VOFF + (db * 32 + l31) * SBW_VPITCH + (kr + 16 * s2 + 8 * lh) * 2);
    done = tile(kf, vf, k0 == r0);
    if (done) break;
  }
  if (!done && wlo > 0) {
#pragma unroll 1
    for (int k0 = wlo - 32; k0 >= 0; k0 -= 32) {
      bf16x8 kf[4], vf[2][2];
#pragma unroll
      for (int s = 0; s < 4; ++s) kf[s] = *(const bf16x8*)(Kg + (size_t)k0 * 512 + 16 * s);
#pragma unroll
      for (int db = 0; db < 2; ++db)
#pragma unroll
        for (int s2 = 0; s2 < 2; ++s2) vf[db][s2] = *(const bf16x8*)(Vg + (size_t)db * 32 * 4096 + k0 + 16 * s2);
      if (tile(kf, vf, false)) break;
    }
  }
  const int t = b * 4096 + r0 + l31;
  u16* dst = (u16*)(ws + WS_SBO) + (size_t)t * 512 + hd * 64;
#pragma unroll
  for (int db = 0; db < 2; ++db)
#pragma unroll
    for (int g = 0; g < 4; ++g) {
      const f32x16& a = o[db];
      *(uint2*)(dst + db * 32 + 8 * g + 4 * lh) = make_uint2(pk_bf16(a[4 * g], a[4 * g + 1]), pk_bf16(a[4 * g + 2], a[4 * g + 3]));
    }
  __syncthreads();
}

DI void phase_attn(const Params& p, char* smem) {
  const int xcd = VXCD, cu = VCU, ncu = gridDim.x >> 3;
  float gq = 0.f, gk = 0.f;
  for (int i = 0; i < 96; ++i) { gq = fmaxf(gq, fabsf(p.q_norm[i])); gk = fmaxf(gk, fabsf(p.k_norm[i])); }
  const float Mb = __int_as_float(__builtin_amdgcn_readfirstlane(__float_as_int(9.797958971132712f * 1.4426950408889634f * gq * gk * 1.01f)));
  for (int w = cu; w < 16 * 4; w += ncu) {
    const int bh = (w / 4) * 8 + xcd, c = w % 4;
#pragma unroll 1
    for (int hf = 0; hf < 2; ++hf) { mla_attn_block512(p, smem, bh >> 3, bh & 7, hf ? c : 7 - c, Mb); __syncthreads(); }
  }
  for (int w = blockIdx.x; w < 256; w += gridDim.x) {
    const int bh = w >> 1, half = w & 1;
#pragma unroll 1
    for (int i = 0; i < 8; ++i) sb_attn_block256(p, smem, bh >> 3, bh & 7, half * 2048 + i * 256);
  }
}
template <int CTRL> DI float dpp_mov(float x) {
  return __uint_as_float(__builtin_amdgcn_update_dpp(0, __float_as_uint(x), CTRL, 0xf, 0xf, true));
}
typedef GemmStream<2, 4, 2, 2, 3, 2> G4;
DI void phase_outproj(const Params& p, char* smem) {
  char* ws = p.ws;
  const int tid = opaque_tid(), lane = tid & 63, wave = tid >> 6;
  const int wp = wave / 4, wq = wave % 4, l31 = lane & 31, lh = lane >> 5;
  const int xcd = VXCD, cu = VCU, ncu = gridDim.x >> 3;
  G4 gs; gs.init(smem, 512, 1024);
  auto seg = [&](int w2) { const int w = w2 >> 1, h = w2 & 1; Seg s; s.P = (const u16*)(ws + (h ? WS_MLAO : WS_SBO)) + (size_t)((w / 4) * 8 + xcd) * 128 * 512;
                           s.Q = (const u16*)(ws + WS_WOT) + (size_t)(w % 4) * 256 * 1024 + h * 512; s.nk = 8; return s; };
  Seg c0 = seg(2 * cu);
  gs.prologue(c0);
  for (int w = cu; w < 64 * 4; w += ncu) {
    const int tt = (w / 4) * 8 + xcd, nt = w % 4;
    const Seg c1 = seg(2 * w + 1);
    const Seg n0 = (w + ncu < 64 * 4) ? seg(2 * (w + ncu)) : c0;
    f32x16 acc0[2][2], acc1[2][2];
    float ss0[2], ss1[2];
    zero_acc(acc0); zero_acc(acc1);
    gs.run(acc0, ss0, c0, c1);
    gs.run(acc1, ss1, c1, n0);
    c0 = n0;
    const int q = lane & 3;
    const bool odd = (q & 1) != 0, hi = (q & 2) != 0;
#pragma unroll
    for (int pb = 0; pb < 2; ++pb) {
      const float r0 = rsqrtf(ss0[pb] * (1.f / 512.f) + 1e-6f), r1 = rsqrtf(ss1[pb] * (1.f / 512.f) + 1e-6f);
#pragma unroll
      for (int g = 0; g < 4; ++g) {
        float s0[4], s1[4];
#pragma unroll
        for (int i = 0; i < 4; ++i) { s0[i] = __shfl(r0, 8 * g + 4 * lh + i, 64); s1[i] = __shfl(r1, 8 * g + 4 * lh + i, 64); }
        const size_t t = (size_t)tt * 128 + wp * 64 + pb * 32 + 8 * g + 4 * lh + q;
#pragma unroll
        for (int qb = 0; qb < 2; ++qb) {
          float a[4];
#pragma unroll
          for (int i = 0; i < 4; ++i) a[i] = s0[i] * acc0[pb][qb][4 * g + i] + s1[i] * acc1[pb][qb][4 * g + i];
          const float t01 = dpp_mov<0xB1>(odd ? a[0] : a[1]), t23 = dpp_mov<0xB1>(odd ? a[2] : a[3]);
          const float b0 = odd ? t01 : a[0], b1 = odd ? a[1] : t01, b2 = odd ? t23 : a[2], b3 = odd ? a[3] : t23;
          const float u0 = dpp_mov<0x4E>(hi ? b0 : b2), u1 = dpp_mov<0x4E>(hi ? b1 : b3);
          const float c0 = hi ? u0 : b0, c1 = hi ? u1 : b1, c2 = hi ? b2 : u0, c3 = hi ? b3 : u1;
          const int n = nt * 256 + wq * 64 + qb * 32 + (l31 & ~3);
          const float4 xv = *(const float4*)(p.x + t * 1024 + n);
          const float4 o = make_float4(xv.x + c0, xv.y + c1, xv.z + c2, xv.w + c3);
          *(uint2*)((u16*)(ws + WS_XB) + t * 1024 + n) = make_uint2(pk_bf16(o.x, o.y), pk_bf16(o.z, o.w));
        }
      }
    }
  }
  gs.drain();
}

DI int f2key(float f) { const int b = __float_as_int(f); return b ^ ((b >> 31) & 0x7fffffff); }
DI float key2f(int k) { return __int_as_float(k ^ ((k >> 31) & 0x7fffffff)); }
#define CE_D(a, b) { const int _mx = max(a, b), _mn = min(a, b); a = _mx; b = _mn; }
template <int N, int OFF>
DI void bitonic_sort_desc(int (&v)[64]) {
#pragma unroll
  for (int k = 2; k <= N; k <<= 1)
#pragma unroll
    for (int j = k >> 1; j > 0; j >>= 1)
#pragma unroll
      for (int i = 0; i < N; ++i) {
        const int l = i ^ j;
        if (l > i) {
          if ((i & k) == 0 || k == N) { CE_D(v[OFF + i], v[OFF + l]); } else { CE_D(v[OFF + l], v[OFF + i]); }
        }
      }
}
DI void bitonic_merge16_desc(int (&v)[16]) {
#pragma unroll
  for (int j = 8; j > 0; j >>= 1)
#pragma unroll
    for (int i = 0; i < 16; ++i) { const int l = i ^ j; if (l > i) { CE_D(v[i], v[l]); } }
}
DI void top16_of_64(int (&v)[64], int (&out)[16]) {
  bitonic_sort_desc<16, 0>(v); bitonic_sort_desc<16, 16>(v); bitonic_sort_desc<16, 32>(v); bitonic_sort_desc<16, 48>(v);
  int a[16], b[16];
#pragma unroll
  for (int i = 0; i < 16; ++i) { a[i] = max(v[i], v[31 - i]); b[i] = max(v[32 + i], v[63 - i]); }
  bitonic_merge16_desc(a); bitonic_merge16_desc(b);
#pragma unroll
  for (int i = 0; i < 16; ++i) out[i] = max(a[i], b[15 - i]);
  bitonic_merge16_desc(out);
}

typedef GemmStream<2, 4, 4, 2, 2, 1> G5;
#define P5_SUBK_OFF 0
#define P5_LIST_OFF 65536
DI void peer_query_tile(const Params& p, char* smem, int tt, int hd) {
  char* ws = p.ws;
  const int tid = opaque_tid(), lane = tid & 63, wave = tid >> 6;
  const int wp = wave / 4, wq = wave % 4, l31 = lane & 31, lh = lane >> 5;
  float ssq[2];
  f32x16 acc[4][2];
  zero_acc(acc);
  {
    G5 gs; gs.init(smem, 1024, 1024);
    Seg cur; cur.P = (const u16*)(ws + WS_WPQT) + (size_t)hd * 256 * 1024; cur.Q = (const u16*)(ws + WS_XB) + (size_t)tt * 256 * 1024; cur.nk = 16;
    gs.prologue(cur);
    gs.run(acc, ssq, cur, cur);
    gs.drain();
  }
  {
    const uint4* src0 = (const uint4*)((const u16*)(ws + WS_SUBK) + (size_t)(0 * 8 + hd) * 128 * 128);
    const uint4* src1 = (const uint4*)((const u16*)(ws + WS_SUBK) + (size_t)(1 * 8 + hd) * 128 * 128);
#pragma unroll
    for (int i = 0; i < 4; ++i) {
      const int ch = tid + i * 512;
      const int key = ch >> 4, cc = ch & 15;
      const int off = key * 256 + ((cc ^ (key & 15)) << 4);
      *(uint4*)(smem + P5_SUBK_OFF + off) = src0[ch];
      *(uint4*)(smem + P5_SUBK_OFF + 32768 + off) = src1[ch];
    }
  }
  __syncthreads();
  const char* sk = smem + P5_SUBK_OFF + wp * 32768;
  int* lists = (int*)(smem + P5_LIST_OFF);
  bf16x8 xf[2][8];
#pragma unroll
  for (int qb = 0; qb < 2; ++qb) {
    const float r2 = rsqrtf(ssq[qb] * (1.f / 1024.f) + 1e-6f);
#pragma unroll
    for (int pb = 0; pb < 4; ++pb)
#pragma unroll
      for (int s2 = 0; s2 < 2; ++s2) {
        const f32x16& a = acc[pb][qb];
        uint4 w = make_uint4(pk_bf16(a[8 * s2] * r2, a[8 * s2 + 1] * r2), pk_bf16(a[8 * s2 + 2] * r2, a[8 * s2 + 3] * r2),
                             pk_bf16(a[8 * s2 + 4] * r2, a[8 * s2 + 5] * r2), pk_bf16(a[8 * s2 + 6] * r2, a[8 * s2 + 7] * r2));
        xf[qb][pb * 2 + s2] = __builtin_bit_cast(bf16x8, w);
      }
  }
#pragma unroll
  for (int qb = 0; qb < 2; ++qb) {
    const int tl = wq * 64 + qb * 32 + l31;
    int keys[64];
#pragma unroll
    for (int kb = 0; kb < 4; ++kb) {
      f32x16 sc;
#pragma unroll
      for (int r = 0; r < 16; ++r) sc[r] = 0.f;
      const int key = kb * 32 + l31;
#pragma unroll
      for (int kk = 0; kk < 8; ++kk) {
        const bf16x8 af = *(const bf16x8*)(sk + key * 256 + (((2 * kk + lh) ^ (key & 15)) << 4));
        sc = MFMA32(af, xf[qb][kk], sc);
      }
#pragma unroll
      for (int r = 0; r < 16; ++r) {
        const int n = kb * 32 + crow(r, lh);
        keys[kb * 16 + r] = f2key(__int_as_float((__float_as_int(sc[r]) & ~127) | n));
      }
    }
    int top[16];
    top16_of_64(keys, top);
    int mrg[16];
#pragma unroll
    for (int i = 0; i < 16; ++i) mrg[i] = __shfl_xor(top[15 - i], 32, 64);
#pragma unroll
    for (int i = 0; i < 16; ++i) mrg[i] = max(mrg[i], top[i]);
    bitonic_merge16_desc(mrg);
    if (lh == 0) {
      int* dst = lists + (wp * 256 + tl) * 16;
#pragma unroll
      for (int g = 0; g < 4; ++g) *(int4*)(dst + 4 * g) = make_int4(mrg[4 * g], mrg[4 * g + 1], mrg[4 * g + 2], mrg[4 * g + 3]);
    }
  }
  __syncthreads();
  if (tid < 256) {
    const int* la = lists + tid * 16;
    const int* lb = lists + (256 + tid) * 16;
    float av[16], bv[16];
#pragma unroll
    for (int i = 0; i < 16; ++i) {
      av[i] = __int_as_float(__float_as_int(key2f(la[i])) & ~127);
      bv[i] = __int_as_float(__float_as_int(key2f(lb[i])) & ~127);
    }
    int cand[64];
    int nc = 0;
#pragma unroll
    for (int i = 0; i < 16; ++i)
#pragma unroll
      for (int j = 0; j < 16; ++j)
        if ((i + 1) * (j + 1) <= 16) {
          const float s = av[i] + bv[j];
          cand[nc] = f2key(__int_as_float((__float_as_int(s) & ~255) | (i * 16 + j)));
          ++nc;
        }
#pragma unroll
    for (int i = 50; i < 64; ++i) cand[i] = (int)0x80000000;
    int best[16];
    top16_of_64(cand, best);
    float sv[16], den = 0.f;
    int ex[16];
    const float smax = key2f(best[0]);
#pragma unroll
    for (int k = 0; k < 16; ++k) {
      const float s = key2f(best[k]);
      const int id = __float_as_int(s) & 255;
      const int n1 = __float_as_int(key2f(la[id >> 4])) & 127;
      const int n2 = __float_as_int(key2f(lb[id & 15])) & 127;
      ex[k] = n1 * 128 + n2;
      sv[k] = __expf(s - smax);
      den += sv[k];
    }
    const float inv = 1.f / den;
    const size_t t = (size_t)tt * 256 + tid;
    int* di = (int*)(ws + WS_IDX) + t * 128 + hd * 16;
    float* dg = (float*)(ws + WS_GATE) + t * 128 + hd * 16;
#pragma unroll
    for (int g = 0; g < 4; ++g) {
      *(int4*)(di + 4 * g) = make_int4(ex[4 * g], ex[4 * g + 1], ex[4 * g + 2], ex[4 * g + 3]);
      *(float4*)(dg + 4 * g) = make_float4(sv[4 * g] * inv, sv[4 * g + 1] * inv, sv[4 * g + 2] * inv, sv[4 * g + 3] * inv);
    }
  }
  __syncthreads();
}
DI void phase_peerq(const Params& p, char* smem) {
  const int xcd = VXCD, cu = VCU, ncu = gridDim.x >> 3;
  for (int w = cu; w < 32 * 8; w += ncu) peer_query_tile(p, smem, (w / 8) * 8 + xcd, w % 8);
}

DI float4 bf16x4_to_f32(uint2 w) { return make_float4(__uint_as_float(w.x << 16), __uint_as_float(w.x & 0xffff0000u), __uint_as_float(w.y << 16), __uint_as_float(w.y & 0xffff0000u)); }
DI float wave_sum(float v) {
  v += shfl_xor_f(v, 32); v += shfl_xor_f(v, 16); v += shfl_xor_f(v, 8); v += shfl_xor_f(v, 4); v += shfl_xor_f(v, 2); v += shfl_xor_f(v, 1);
  return v;
}
DI float reduce8(const float (&d)[8], int lane) {
  float r1[4], r2[2];
#pragma unroll
  for (int m = 0; m < 4; ++m) {
    auto r = __builtin_amdgcn_permlane32_swap(__float_as_uint(d[m]), __float_as_uint(d[m + 4]), false, false);
    r1[m] = __uint_as_float(r[0]) + __uint_as_float(r[1]);
  }
#pragma unroll
  for (int m = 0; m < 2; ++m) {
    auto r = __builtin_amdgcn_permlane16_swap(__float_as_uint(r1[m]), __float_as_uint(r1[m + 2]), false, false);
    r2[m] = __uint_as_float(r[0]) + __uint_as_float(r[1]);
  }
  const bool b3 = (lane & 8) != 0;
  const float keep = b3 ? r2[1] : r2[0], send = b3 ? r2[0] : r2[1];
  float s = keep + dpp_mov<0x128>(send);
  s += dpp_mov<0x141>(s);
  s += dpp_mov<0xB1>(s);
  s += dpp_mov<0x4E>(s);
  return s;
}
template <int CTRL> DI int dpp_movi(int x) { return __builtin_amdgcn_update_dpp(0, x, CTRL, 0xf, 0xf, true); }
DI int reduce8i(const int (&d)[8], int lane) {
  int r1[4], r2[2];
#pragma unroll
  for (int m = 0; m < 4; ++m) {
    auto r = __builtin_amdgcn_permlane32_swap((u32)d[m], (u32)d[m + 4], false, false);
    r1[m] = (int)(r[0] + r[1]);
  }
#pragma unroll
  for (int m = 0; m < 2; ++m) {
    auto r = __builtin_amdgcn_permlane16_swap((u32)r1[m], (u32)r1[m + 2], false, false);
    r2[m] = (int)(r[0] + r[1]);
  }
  const bool b3 = (lane & 8) != 0;
  const int keep = b3 ? r2[1] : r2[0], send = b3 ? r2[0] : r2[1];
  int s = keep + dpp_movi<0x128>(send);
  s += dpp_movi<0x141>(s);
  s += dpp_movi<0xB1>(s);
  s += dpp_movi<0x4E>(s);
  return s;
}
DI float wave_max(float v) {
  v = fmaxf(v, shfl_xor_f(v, 32)); v = fmaxf(v, shfl_xor_f(v, 16)); v = fmaxf(v, shfl_xor_f(v, 8));
  v = fmaxf(v, shfl_xor_f(v, 4)); v = fmaxf(v, shfl_xor_f(v, 2)); v = fmaxf(v, shfl_xor_f(v, 1));
  return v;
}
DI u32 pack_i8x4(float a, float b, float c, float d) {
  const int ia = __float2int_rn(a), ib = __float2int_rn(b), ic = __float2int_rn(c), id = __float2int_rn(d);
  return ((u32)ia & 255u) | (((u32)ib & 255u) << 8) | (((u32)ic & 255u) << 16) | ((u32)id << 24);
}
DI float gelu_erf(float x) {
  const float z = fabsf(x) * 0.7071067811865476f;
  const float t = __builtin_amdgcn_rcpf(1.f + 0.3275911f * z);
  const float poly = t * (0.254829592f + t * (-0.284496736f + t * (1.421413741f + t * (-1.453152027f + t * 1.061405429f))));
  const float e = 1.f - poly * __builtin_amdgcn_exp2f(-z * z * 1.4426950408889634f);
  return 0.5f * x * (1.f + copysignf(e, x));
}
typedef unsigned v3u __attribute__((ext_vector_type(3)));
typedef unsigned v4u __attribute__((ext_vector_type(4)));
typedef unsigned v6u __attribute__((ext_vector_type(6)));
typedef float v32f __attribute__((ext_vector_type(32)));
DI v32f cvt_rows(const uint3& ra, const uint3& rb, u32 z) {
  v6u w; w[0] = ra.x; w[1] = ra.y; w[2] = ra.z; w[3] = rb.x | z; w[4] = rb.y | z; w[5] = rb.z | z;
  return __builtin_amdgcn_cvt_scalef32_pk32_f32_fp6(w, 1.0f);
}
DI void axpy_rows(const uint3& ra, const uint3& rb, u32 z, float ca, float cb, f32x2 (&acc)[8]) {
  const v32f f = cvt_rows(ra, rb, z);
  const f32x2 ca2 = {ca, ca}, cb2 = {cb, cb};
#pragma unroll
  for (int m = 0; m < 8; ++m) {
    acc[m] = ca2 * f32x2{f[2 * m], f[2 * m + 1]} + acc[m];
    acc[m] = cb2 * f32x2{f[16 + 2 * m], f[17 + 2 * m]} + acc[m];
  }
}
#ifndef P6_PACE
#define P6_PACE 1
#endif
#ifndef P6_PACE_MASK
#define P6_PACE_MASK 14
#endif
#ifndef P6_GROUP_PACE
#define P6_GROUP_PACE 0
#endif
#ifndef P6_YOUNG_PRIO
#define P6_YOUNG_PRIO 0
#endif
#define P6_ENT_E 0
#define P6_ENT_C 2048
#define P6_ENT_G 4096
#define P6_CNT   6144
#define P6_WAVE_BYTES 6400
DI void xcd_group_pace(unsigned* cnt, unsigned target) {
  if ((opaque_tid() & (NTHREADS - 1)) == 0) {
    __hip_atomic_fetch_add(cnt, 1u, __ATOMIC_RELAXED, __HIP_MEMORY_SCOPE_AGENT);
    for (int sp = 0; sp < 4000; ++sp) {
      if (__hip_atomic_load(cnt, __ATOMIC_RELAXED, __HIP_MEMORY_SCOPE_AGENT) >= target) break;
      __builtin_amdgcn_s_sleep(8);
    }
  }
  __syncthreads();
}
DI void phase_experts(const Params& p, char* smem) {
  char* ws = p.ws;
  const int wave = opaque_tid() >> 6;
  const int xcd = VXCD, cu = VCU, ncu = gridDim.x >> 3;
  const __amdgpu_buffer_rsrc_t U8 = __builtin_amdgcn_make_buffer_rsrc((void*)(ws + WS_UB), 0, 16 << 20, 0x00020000);
  const __amdgpu_buffer_rsrc_t V8 = __builtin_amdgcn_make_buffer_rsrc((void*)(ws + WS_VB), 0, 16 << 20, 0x00020000);
  const float* usc = (const float*)(ws + WS_USC);
  const float* vsc = (const float*)(ws + WS_VSC);
  char* wl = smem + wave * P6_WAVE_BYTES;
  u32* ent_e = (u32*)(wl + P6_ENT_E);
  float* ent_c = (float*)(wl + P6_ENT_C);
  float* ent_g = (float*)(wl + P6_ENT_G);
  int* cnt = (int*)(wl + P6_CNT);
  const int tok_per_round = ncu * 32;
  unsigned* pace = (unsigned*)(ws + WS_END + 49152) + 64 * xcd;
  unsigned pace_n = 0;
  const int tok_per_xcd = NTOK / 8;
#ifdef P6_STAMP
  unsigned long long ts[5] = {0, 0, 0, 0, 0};
#define P6_T(i) do { __builtin_amdgcn_sched_barrier(0); unsigned long long _t; asm volatile("s_waitcnt vmcnt(0) lgkmcnt(0)\n\ts_memtime %0\n\ts_waitcnt lgkmcnt(0)" : "=s"(_t) :: "memory"); ts[i] += _t - tprev; tprev = _t; __builtin_amdgcn_sched_barrier(0); } while (0)
  unsigned long long tprev; asm volatile("s_memtime %0\n\ts_waitcnt lgkmcnt(0)" : "=s"(tprev) :: "memory");
#else
#define P6_T(i) do { } while (0)
#endif
  int e_n[4][2];
  float gt_n[4][2], us_n[4][2], vs_n[4][2];
  auto prefetch_idx = [&](int t0n) {
    const int ln = opaque_tid() & 63;
#pragma unroll
    for (int k = 0; k < 4; ++k) {
      const int* idx = (const int*)(ws + WS_IDX) + (size_t)(t0n + k) * 128;
      const float* gate = (const float*)(ws + WS_GATE) + (size_t)(t0n + k) * 128;
#pragma unroll
      for (int h = 0; h < 2; ++h) { e_n[k][h] = idx[64 * h + ln]; gt_n[k][h] = gate[64 * h + ln]; }
    }
  };
  auto prefetch_sc = [&]() {
#pragma unroll
    for (int k = 0; k < 4; ++k)
#pragma unroll
      for (int h = 0; h < 2; ++h) { us_n[k][h] = usc[e_n[k][h]]; vs_n[k][h] = vsc[e_n[k][h]]; }
  };
  prefetch_idx(xcd * tok_per_xcd + cu * 32 + wave * 4);
  prefetch_sc();
#if P6_YOUNG_PRIO
  if (__builtin_amdgcn_readfirstlane(wave) >= 4) __builtin_amdgcn_s_setprio(1);
#endif
#pragma unroll 1
  for (int rb = cu * 32; rb < tok_per_xcd; rb += tok_per_round) {
    const int t0 = xcd * tok_per_xcd + rb + wave * 4;
    const int lane = opaque_tid() & 63;
    const unsigned lane_off = lane * 12;
    u32 zero; asm volatile("s_mov_b32 %0, 0" : "=s"(zero));
    const int jq = 128 * ((lane & 7) >> 1) + (lane & 1);
    const int jr = 128 * ((lane >> 3) >> 1) + ((lane >> 3) & 1);
    u32 xq[4][4];
    float r2[4];
#pragma unroll
    for (int k = 0; k < 4; ++k) {
      const u16* xrow = (const u16*)(ws + WS_XB) + (size_t)(t0 + k) * 1024 + 4 * lane;
      float4 a[4];
      float ss = 0.f, mx = 0.f;
#pragma unroll
      for (int i = 0; i < 4; ++i) {
        a[i] = bf16x4_to_f32(*(const uint2*)(xrow + 256 * i));
        ss += a[i].x * a[i].x + a[i].y * a[i].y + a[i].z * a[i].z + a[i].w * a[i].w;
        mx = fmaxf(mx, fmaxf(fmaxf(fabsf(a[i].x), fabsf(a[i].y)), fmaxf(fabsf(a[i].z), fabsf(a[i].w))));
      }
      ss = wave_sum(ss);
      mx = wave_max(mx);
      const float qs = (mx > 0.f) ? 127.f / mx : 1.f;
#pragma unroll
      for (int i = 0; i < 4; ++i) xq[k][i] = pack_i8x4(a[i].x * qs, a[i].y * qs, a[i].z * qs, a[i].w * qs);
      r2[k] = rsqrtf(ss * (1.f / 1024.f) + 1e-6f) * ((mx > 0.f) ? mx * (1.f / 127.f) : 1.f);
    }
    P6_T(0);
    cnt[lane] = 0;
    {
      int e_[4][2], pos_[4][2];
      float c_[4][2], g_[4][2];
#pragma unroll
      for (int k = 0; k < 4; ++k) {
#pragma unroll
        for (int h = 0; h < 2; ++h) {
          const int e = e_n[k][h];
          e_[k][h] = e;
          c_[k][h] = r2[k] * us_n[k][h];
          g_[k][h] = gt_n[k][h] * vs_n[k][h];
          pos_[k][h] = atomicAdd(&cnt[k * 16 + (e >> 10)], 1);
        }
      }
      const int c = cnt[lane];
      int incl = c;
#pragma unroll
      for (int d = 1; d < 64; d <<= 1) { const int v = __shfl_up(incl, d, 64); if (lane >= d) incl += v; }
      cnt[lane] = incl - c;
#pragma unroll
      for (int k = 0; k < 4; ++k)
#pragma unroll
        for (int h = 0; h < 2; ++h) {
          const int e = e_[k][h];
          const int q = cnt[k * 16 + (e >> 10)] + pos_[k][h];
          ent_e[q] = (u32)e;
          ent_c[q] = c_[k][h];
          ent_g[q] = g_[k][h];
        }
    }
    P6_T(1);
    {
      uint4 ra[8], rb8[8];
      auto issue = [&](int g_, uint4 (&rr)[8]) {
        const int g = (g_ < 64) ? g_ : 63;
        const u32 ev = ent_e[jq + 2 * g] << 10;
#pragma unroll
        for (int j = 0; j < 8; ++j) {
          const v4u w = __builtin_amdgcn_raw_buffer_load_b128(U8, lane * 16, (u32)__builtin_amdgcn_readlane((int)ev, j), 0);
          rr[j] = make_uint4(w.x, w.y, w.z, w.w);
        }
        __builtin_amdgcn_sched_barrier(0);
      };
      auto compute_u = [&](int g, const uint4 (&rr)[8]) {
        int d[8];
#pragma unroll
        for (int j = 0; j < 8; ++j) {
          int a = __builtin_amdgcn_sdot4((int)rr[j].x, (int)xq[j >> 1][0], 0, false);
          a = __builtin_amdgcn_sdot4((int)rr[j].y, (int)xq[j >> 1][1], a, false);
          a = __builtin_amdgcn_sdot4((int)rr[j].z, (int)xq[j >> 1][2], a, false);
          d[j] = __builtin_amdgcn_sdot4((int)rr[j].w, (int)xq[j >> 1][3], a, false);
        }
        const int tot = reduce8i(d, lane);
        const int q = jr + 2 * g;
        const float pre = (float)tot * ent_c[q];
        const float cf = ent_g[q] * gelu_erf(pre);
        if ((lane & 7) == 0) ent_c[q] = cf;
      };
      issue(0, ra);
#pragma unroll 1
      for (int g = 0; g < 64; g += 2) {
        issue(g + 1, rb8); compute_u(g, ra);
        issue(g + 2, ra);  compute_u(g + 1, rb8);
        if (P6_PACE && (g & P6_PACE_MASK) == P6_PACE_MASK) __syncthreads();
      }
    }
    P6_T(2);
    uint3 ra[8], rb8[8];
    auto issue = [&](__amdgpu_buffer_rsrc_t tab, int g_, uint3 (&rr)[8]) {
      const int g = (g_ < 64) ? g_ : 63;
      const u32 ev = ent_e[jq + 2 * g] * 768u;
#pragma unroll
      for (int j = 0; j < 8; ++j) {
        const v3u w = __builtin_amdgcn_raw_buffer_load_b96(tab, lane_off, (u32)__builtin_amdgcn_readlane((int)ev, j), 0);
        rr[j] = make_uint3(w.x, w.y, w.z);
      }
      __builtin_amdgcn_sched_barrier(0);
    };
    f32x2 acc[4][8];
#pragma unroll
    for (int k = 0; k < 4; ++k)
#pragma unroll
      for (int i = 0; i < 8; ++i) acc[k][i] = f32x2{0.f, 0.f};
    auto compute_v = [&](int g, const uint3 (&rr)[8]) {
      const float cl = ent_c[jq + 2 * g];
#pragma unroll
      for (int k = 0; k < 4; ++k)
        axpy_rows(rr[2 * k], rr[2 * k + 1], zero, __int_as_float(__builtin_amdgcn_readlane(__float_as_int(cl), 2 * k)),
                  __int_as_float(__builtin_amdgcn_readlane(__float_as_int(cl), 2 * k + 1)), acc[k]);
    };
#if P6_GROUP_PACE
    xcd_group_pace(pace, (++pace_n) * ncu);
#endif
    {
      const int rbn = (rb + tok_per_round < tok_per_xcd) ? rb + tok_per_round : rb;
      prefetch_idx(xcd * tok_per_xcd + rbn + wave * 4);
    }
    issue(V8, 0, ra);
#pragma unroll 1
    for (int g = 0; g < 64; g += 2) {
      issue(V8, g + 1, rb8); compute_v(g, ra);
      issue(V8, g + 2, ra);  compute_v(g + 1, rb8);
      if (P6_PACE && (g & P6_PACE_MASK) == P6_PACE_MASK) __syncthreads();
    }
    prefetch_sc();
    P6_T(3);
#pragma unroll
    for (int k = 0; k < 4; ++k) {
      float* orow = p.out + (size_t)(t0 + k) * 1024 + 4 * lane;
      const u16* xrow = (const u16*)(ws + WS_XB) + (size_t)(t0 + k) * 1024 + 4 * lane;
#pragma unroll
      for (int i = 0; i < 4; ++i) {
        const float4 a = bf16x4_to_f32(*(const uint2*)(xrow + 256 * i));
        *(float4*)(orow + 256 * i) = make_float4(a.x + acc[k][2 * i][0], a.y + acc[k][2 * i][1], a.z + acc[k][2 * i + 1][0], a.w + acc[k][2 * i + 1][1]);
      }
    }
    P6_T(4);
  }
#if P6_YOUNG_PRIO
  __builtin_amdgcn_s_setprio(0);
#endif
#ifdef P6_STAMP
  if (blockIdx.x == P6_STAMP_BLK && wave == P6_STAMP_WAVE && (opaque_tid() & 63) == 0) {
    unsigned long long* d = (unsigned long long*)(ws + WS_END + 32768);
    for (int i = 0; i < 5; ++i) d[i] = ts[i];
  }
#endif
}

#define XB_TMO      128
#define XB_XCNT(j)  (256  + 64 * (j))
#define XB_XSUB(j)  (1280 + 64 * (j))
#define XB_XGEN(j)  (2304 + 64 * (j))
#define XB_TOP      3328
#define XB_TOPGEN   3392
#define XCD_BAR_WORDS 3456
#define XB_SPIN_CAP (1u << 20)
#define LAS __attribute__((address_space(3)))
DI unsigned xb_ld(unsigned* p) { return __hip_atomic_load(p, __ATOMIC_RELAXED, __HIP_MEMORY_SCOPE_AGENT); }
DI unsigned xb_add(unsigned* p, unsigned v) { return __hip_atomic_fetch_add(p, v, __ATOMIC_RELAXED, __HIP_MEMORY_SCOPE_AGENT); }
DI unsigned xb_xcc_id() { return (unsigned)__builtin_amdgcn_s_getreg((3 << 11) | 20) & 0xFu; }
#define XB_SPIN(cond, bar) do { unsigned _sp = 0; while (cond) { __builtin_amdgcn_s_sleep(1); \
    if ((++_sp & 255u) == 0u) { if (xb_ld(&(bar)[XB_TMO])) break; if (_sp > XB_SPIN_CAP) { atomicAdd(&(bar)[XB_TMO], 1u); break; } } } } while (0)
struct XcdBarrier { unsigned* bar; unsigned x; volatile LAS unsigned* st; };
DI XcdBarrier xcd_barrier_post(unsigned* bar, volatile LAS unsigned* st) {
  XcdBarrier b; b.bar = bar; b.x = xb_xcc_id(); b.st = st;
  if (threadIdx.x == 0) (void)xb_add(&bar[XB_XCNT(b.x)], 1u);
  return b;
}
DI void xcd_barrier_complete(unsigned* bar, unsigned x, unsigned& nloc, unsigned& nx) {
  const unsigned G = gridDim.x * gridDim.y * gridDim.z;
  unsigned sum, cnt, mine, sp = 0u;
  for (;;) {
    sum = 0u; cnt = 0u; mine = 0u;
#pragma unroll
    for (unsigned j = 0; j < 16; ++j) { const unsigned c = xb_ld(&bar[XB_XCNT(j)]); sum += c; cnt += (c > 0u) ? 1u : 0u; mine = (j == x) ? c : mine; }
    if (sum == G) break;
    __builtin_amdgcn_s_sleep(1);
    if ((++sp & 255u) == 0u) { if (xb_ld(&bar[XB_TMO])) break; if (sp > XB_SPIN_CAP) { atomicAdd(&bar[XB_TMO], 1u); break; } }
  }
  nloc = mine > 0u ? mine : 1u; nx = cnt > 0u ? cnt : 1u;
}
DI void xcd_barrier(const XcdBarrier& b) {
  asm volatile("s_waitcnt vmcnt(0)" ::: "memory");
  __syncthreads();
  if (threadIdx.x == 0) {
    unsigned* bar = b.bar;
    __builtin_amdgcn_s_waitcnt(0);
    unsigned nloc = b.st[0], nx = b.st[1];
    if (nloc == 0u) { xcd_barrier_complete(bar, b.x, nloc, nx); b.st[0] = nloc; b.st[1] = nx; }
    const unsigned old = xb_add(&bar[XB_XSUB(b.x)], 1u);
    const unsigned gen = old / nloc;
    if (old + 1u == (gen + 1u) * nloc) {
      __builtin_amdgcn_fence(__ATOMIC_RELEASE, "agent");
      asm volatile("s_waitcnt vmcnt(0)" ::: "memory");
      const unsigned og = xb_add(&bar[XB_TOP], 1u);
      const unsigned tg = og / nx;
      if (og + 1u == (tg + 1u) * nx) xb_add(&bar[XB_TOPGEN], 1u);
      else XB_SPIN(xb_ld(&bar[XB_TOPGEN]) == tg, bar);
      __builtin_amdgcn_fence(__ATOMIC_ACQUIRE, "agent");
      xb_add(&bar[XB_XGEN(b.x)], 1u);
      asm volatile("s_waitcnt vmcnt(0)" ::: "memory");
    } else {
      XB_SPIN(xb_ld(&bar[XB_XGEN(b.x)]) == gen, bar);
      __builtin_amdgcn_fence(__ATOMIC_ACQUIRE, "agent");
      asm volatile("s_waitcnt vmcnt(0)" ::: "memory");
    }
  }
  __syncthreads();
}

#define LDS_TOTAL 155648
#define LDS_ALLOC (LDS_TOTAL + 16)
#define WS_BAR WS_END
#define N_PHASES 7
#ifndef N_LAUNCH_SPLIT
#define N_LAUNCH_SPLIT 0
#endif
__global__ void __launch_bounds__(NTHREADS) mega_fwd(Params p) {
  extern __shared__ __attribute__((aligned(16))) char smem[];
  cg::grid_group grid = cg::this_grid();
  volatile LAS unsigned* xst = (volatile LAS unsigned*)(smem + LDS_TOTAL);
  if (threadIdx.x == 0) { xst[0] = 0u; xst[1] = 0u; xst[2] = 0u; xst[3] = 0u; }
  if (blockIdx.x == 0) for (int i = opaque_tid(); i < XCD_BAR_WORDS; i += NTHREADS) ((unsigned*)(p.ws + WS_BAR))[i] = 0u;
  __syncthreads();
  XcdBarrier xb; xb.bar = (unsigned*)(p.ws + WS_BAR); xb.x = 0; xb.st = xst;
#ifndef DOUBLE_MASK
#define DOUBLE_MASK 0
#endif
#define GRID_SYNC(k) do { if ((k) == 0) { __threadfence(); grid.sync(); xb = xcd_barrier_post((unsigned*)(p.ws + WS_BAR), xst); } else xcd_barrier(xb); } while (0)
#ifdef PH_STAMP
#define PH_MARK(k) do { if (blockIdx.x == 0 && threadIdx.x == 0) { const unsigned long long _t = __builtin_amdgcn_s_memrealtime(); ((unsigned long long*)(p.ws + WS_END + 40960))[k] = _t; } } while (0)
#else
#define PH_MARK(k) do { } while (0)
#endif
#if N_LAUNCH_SPLIT
#define RUN_PHASE(k, call) if (p.ph_lo <= (k) && (k) < p.ph_hi) { PH_MARK(k); call; if ((DOUBLE_MASK >> (k)) & 1) { GRID_SYNC(k); call; } if ((k) + 1 < p.ph_hi) GRID_SYNC(k); }
#else
#define RUN_PHASE(k, call) { PH_MARK(k); call; if ((DOUBLE_MASK >> (k)) & 1) { GRID_SYNC(k); call; } if ((k) + 1 < N_PHASES) GRID_SYNC(k); }
#endif
  RUN_PHASE(0, phase_prep(p, smem))
  RUN_PHASE(1, phase_inproj(p, smem))
  RUN_PHASE(2, phase_mlaproj(p, smem))
  RUN_PHASE(3, phase_attn(p, smem))
  RUN_PHASE(4, phase_outproj(p, smem))
  RUN_PHASE(5, phase_peerq(p, smem))
  RUN_PHASE(6, phase_experts(p, smem))
#ifdef PH_STAMP
  PH_MARK(7);
  xcd_barrier(xb);
  if (blockIdx.x == 0 && threadIdx.x == 0) {
    unsigned long long* d = (unsigned long long*)(p.ws + WS_END + 40960);
    d[8] = __builtin_amdgcn_s_memrealtime();
    p.out[0] += (float)((double)(d[PH_STAMP_B] - d[PH_STAMP_A]) * 0.00001 * PH_SCALE);
  }
#endif
#ifdef FP6_PROBE
  xcd_barrier(xb);
  if (blockIdx.x == 0 && threadIdx.x < 64) {
    typedef unsigned v6u_t __attribute__((ext_vector_type(6)));
    typedef float v32f_t __attribute__((ext_vector_type(32)));
    const int lane = threadIdx.x;
    unsigned w[7] = {0u, 0u, 0u, 0u, 0u, 0u, 0u};
    int bad = 0;
#pragma unroll
    for (int i = 0; i < 32; ++i) {
      const unsigned c = (unsigned)((i + 32 * (lane & 1)) & 63);
      const int off = 6 * i, wd = off >> 5, sh = off & 31;
      w[wd] |= c << sh;
      if (sh > 26) w[wd + 1] |= c >> (32 - sh);
    }
    v6u_t a; a[0] = w[0]; a[1] = w[1]; a[2] = w[2]; a[3] = w[3]; a[4] = w[4]; a[5] = w[5];
    const v32f_t r = __builtin_amdgcn_cvt_scalef32_pk32_f32_fp6(a, 1.0f);
#pragma unroll
    for (int i = 0; i < 32; ++i) {
      const int c = (i + 32 * (lane & 1)) & 63;
      const int e = (c >> 3) & 3, m = c & 7;
      float v = (e == 0) ? (float)m * 0.125f : (1.f + (float)m * 0.125f) * (float)(1 << (e - 1));
      if (c & 32) v = -v;
      if (r[i] != v) ++bad;
    }
    bad = __builtin_amdgcn_readfirstlane(bad) | __builtin_amdgcn_readlane(bad, 1);
    v32f_t r0 = r, r1 = r, r2, r3;
    unsigned long long t0, t1;
    asm volatile("s_waitcnt vmcnt(0) lgkmcnt(0)\n\ts_memtime %0\n\ts_waitcnt lgkmcnt(0)" : "=s"(t0) :: "memory");
#pragma unroll 1
    for (int it = 0; it < 256; ++it) {
#if FP6_PROBE == 1
      asm volatile("v_cvt_scalef32_pk32_f32_fp6 %0, %4, 1.0\n\tv_cvt_scalef32_pk32_f32_fp6 %1, %4, 1.0\n\tv_cvt_scalef32_pk32_f32_fp6 %2, %4, 1.0\n\tv_cvt_scalef32_pk32_f32_fp6 %3, %4, 1.0"
                   : "=v"(r0), "=v"(r1), "=v"(r2), "=v"(r3) : "v"(a));
#elif FP6_PROBE == 3
      asm volatile("v_fma_f32 %0, %2, %2, %0\n\tv_fma_f32 %1, %2, %2, %1\n\tv_fma_f32 %0, %2, %2, %0\n\tv_fma_f32 %1, %2, %2, %1\n\t"
                   "v_fma_f32 %0, %2, %2, %0\n\tv_fma_f32 %1, %2, %2, %1\n\tv_fma_f32 %0, %2, %2, %0\n\tv_fma_f32 %1, %2, %2, %1\n\t"
                   "v_fma_f32 %0, %2, %2, %0\n\tv_fma_f32 %1, %2, %2, %1\n\tv_fma_f32 %0, %2, %2, %0\n\tv_fma_f32 %1, %2, %2, %1\n\t"
                   "v_fma_f32 %0, %2, %2, %0\n\tv_fma_f32 %1, %2, %2, %1\n\tv_fma_f32 %0, %2, %2, %0\n\tv_fma_f32 %1, %2, %2, %1"
                   : "+v"(r0[0]), "+v"(r1[0]) : "v"(w[0]));
#elif FP6_PROBE == 5
      asm volatile("v_fma_f32 %0, %16, %16, %16\n\tv_fma_f32 %1, %16, %16, %16\n\tv_fma_f32 %2, %16, %16, %16\n\tv_fma_f32 %3, %16, %16, %16\n\tv_fma_f32 %4, %16, %16, %16\n\tv_fma_f32 %5, %16, %16, %16\n\tv_fma_f32 %6, %16, %16, %16\n\tv_fma_f32 %7, %16, %16, %16\n\tv_fma_f32 %8, %16, %16, %16\n\tv_fma_f32 %9, %16, %16, %16\n\tv_fma_f32 %10, %16, %16, %16\n\tv_fma_f32 %11, %16, %16, %16\n\tv_fma_f32 %12, %16, %16, %16\n\tv_fma_f32 %13, %16, %16, %16\n\tv_fma_f32 %14, %16, %16, %16\n\tv_fma_f32 %15, %16, %16, %16" : "=v"(r0[0]), "=v"(r0[1]), "=v"(r0[2]), "=v"(r0[3]), "=v"(r0[4]), "=v"(r0[5]), "=v"(r0[6]), "=v"(r0[7]), "=v"(r1[0]), "=v"(r1[1]), "=v"(r1[2]), "=v"(r1[3]), "=v"(r1[4]), "=v"(r1[5]), "=v"(r1[6]), "=v"(r1[7]) : "v"(w[0]));
#elif FP6_PROBE == 7
      asm volatile("s_sleep 16" ::: "memory");
#elif FP6_PROBE == 4
      asm volatile("v_pk_fma_f32 %0, %2, %2, %0\n\tv_pk_fma_f32 %1, %2, %2, %1\n\tv_pk_fma_f32 %0, %2, %2, %0\n\tv_pk_fma_f32 %1, %2, %2, %1\n\t"
                   "v_pk_fma_f32 %0, %2, %2, %0\n\tv_pk_fma_f32 %1, %2, %2, %1\n\tv_pk_fma_f32 %0, %2, %2, %0\n\tv_pk_fma_f32 %1, %2, %2, %1\n\t"
                   "v_pk_fma_f32 %0, %2, %2, %0\n\tv_pk_fma_f32 %1, %2, %2, %1\n\tv_pk_fma_f32 %0, %2, %2, %0\n\tv_pk_fma_f32 %1, %2, %2, %1\n\t"
                   "v_pk_fma_f32 %0, %2, %2, %0\n\tv_pk_fma_f32 %1, %2, %2, %1\n\tv_pk_fma_f32 %0, %2, %2, %0\n\tv_pk_fma_f32 %1, %2, %2, %1"
                   : "+v"(*(f32x2*)&r0), "+v"(*(f32x2*)&r1) : "v"(*(f32x2*)&w[0]));
#else
      asm volatile("v_cvt_pk_f32_fp8 %0, %2\n\tv_cvt_pk_f32_fp8 %1, %2 src0_sel:WORD_1\n\tv_cvt_pk_f32_fp8 %0, %2\n\tv_cvt_pk_f32_fp8 %1, %2 src0_sel:WORD_1\n\t"
                   "v_cvt_pk_f32_fp8 %0, %2\n\tv_cvt_pk_f32_fp8 %1, %2 src0_sel:WORD_1\n\tv_cvt_pk_f32_fp8 %0, %2\n\tv_cvt_pk_f32_fp8 %1, %2 src0_sel:WORD_1\n\t"
                   "v_cvt_pk_f32_fp8 %0, %2\n\tv_cvt_pk_f32_fp8 %1, %2 src0_sel:WORD_1\n\tv_cvt_pk_f32_fp8 %0, %2\n\tv_cvt_pk_f32_fp8 %1, %2 src0_sel:WORD_1\n\t"
                   "v_cvt_pk_f32_fp8 %0, %2\n\tv_cvt_pk_f32_fp8 %1, %2 src0_sel:WORD_1\n\tv_cvt_pk_f32_fp8 %0, %2\n\tv_cvt_pk_f32_fp8 %1, %2 src0_sel:WORD_1"
                   : "=v"(*(f32x2*)&r0), "=v"(*(f32x2*)&r1) : "v"(w[0]));
#endif
    }
    asm volatile("s_memtime %0\n\ts_waitcnt lgkmcnt(0)" : "=s"(t1) :: "memory");
    float sink = 0.f;
#if FP6_PROBE == 1
    sink = (r0[3] + r1[5] + r2[7] + r3[9]) * 0.f;
    const float cyc = (float)(t1 - t0) * (1.f / 1024.f);
#else
    sink = (r0[0] + r1[1]) * 0.f;
    const float cyc = (float)(t1 - t0) * (1.f / 256.f) * (FP6_PROBE == 7 ? 1.f / 16.f : 1.f);
#endif
    if (lane == 0) p.out[0] += (floorf(cyc + 0.5f) + sink) * (bad ? 1000.f : 1.f);
  }
#endif
#ifdef P6_STAMP
  xcd_barrier(xb);
  if (blockIdx.x == 0 && threadIdx.x == 0) {
    const unsigned long long* d = (const unsigned long long*)(p.ws + WS_END + 32768);
    p.out[0] += (float)((double)d[P6_STAMP] * 1e-5);
  }
#endif
#ifdef GS_STAMP
  xcd_barrier(xb);
  if (blockIdx.x == 0 && threadIdx.x == 0) {
    const unsigned long long* d = (const unsigned long long*)(p.ws + WS_END + 32768);
    p.out[0] += (float)((double)d[GS_STAMP_SEL] * 1e-3);
  }
#endif
}

extern "C" void kernel_launch(void* const* d_in, const int* in_sizes, int n_in, void* d_out, int out_size, void* d_ws,
                              size_t ws_size, hipStream_t stream) {
  static int grid = 0;
  if (grid == 0) {
    if (n_in != 18 || out_size != NTOK * 1024 || ws_size < WS_END + 65536) {
      fprintf(stderr, "kernel_launch: unexpected shapes (n_in %d out %d ws %zu need %llu)\n", n_in, out_size, ws_size, (unsigned long long)WS_END);
      grid = -1; return;
    }
    int dev = 0, cus = 0, per_cu = 0;
    hipGetDevice(&dev);
    hipDeviceGetAttribute(&cus, hipDeviceAttributeMultiprocessorCount, dev);
    hipFuncSetAttribute((const void*)mega_fwd, hipFuncAttributeMaxDynamicSharedMemorySize, LDS_ALLOC);
    hipOccupancyMaxActiveBlocksPerMultiprocessor(&per_cu, (const void*)mega_fwd, NTHREADS, LDS_ALLOC);
    if (per_cu < 1) { fprintf(stderr, "kernel_launch: occupancy query says %d blocks/CU\n", per_cu); grid = -1; return; }
    grid = cus;
    grid -= grid % 8;
    fprintf(stderr, "kernel_launch: grid %d (cus %d, per_cu %d)\n", grid, cus, per_cu);
  }
  if (grid < 0) return;
  Params p{};
  p.x = (const float*)d_in[0]; p.pos = (const int*)d_in[1]; p.attn_norm = (const float*)d_in[2]; p.w_in = (const float*)d_in[3];
  p.cq_norm = (const float*)d_in[4]; p.w_uq = (const float*)d_in[5]; p.ckv_norm = (const float*)d_in[6]; p.w_ukv = (const float*)d_in[7];
  p.q_norm = (const float*)d_in[8]; p.k_norm = (const float*)d_in[9]; p.sb_out_norm = (const float*)d_in[10];
  p.mla_out_norm = (const float*)d_in[11]; p.w_o = (const float*)d_in[12]; p.ffn_norm = (const float*)d_in[13];
  p.peer_wq = (const float*)d_in[14]; p.peer_sk = (const float*)d_in[15]; p.peer_u = (const float*)d_in[16]; p.peer_v = (const float*)d_in[17];
  p.out = (float*)d_out; p.ws = (char*)d_ws;
#if N_LAUNCH_SPLIT
  for (int ph = 0; ph < N_PHASES; ++ph) {
    p.ph_lo = ph; p.ph_hi = ph + 1;
    hipLaunchKernelGGL(mega_fwd, dim3(grid), dim3(NTHREADS), LDS_ALLOC, stream, p);
  }
#else
  p.ph_lo = 0; p.ph_hi = N_PHASES;
  void* args[] = {&p};
  hipError_t e = hipLaunchCooperativeKernel((const void*)mega_fwd, dim3(grid), dim3(NTHREADS), args, LDS_ALLOC, stream);
  if (e != hipSuccess) fprintf(stderr, "cooperative launch failed: %s (grid %d)\n", hipGetErrorString(e), grid);
#endif
}
```
